# Optimizing an MI355X kernel written in HIP

```python
import jax, jax.numpy as jnp
from jax import lax
import numpy as np

D_MODEL = 1024
BATCH = 8
SEQ = 4096
DEPTH = 1

MEM_LEN = 256
MIX_WIDTH = D_MODEL
CONV_CH = MIX_WIDTH // 2
CONV_WIDTH = 31
CONV_PAD = CONV_WIDTH // 2
HEAD_DIM = 64
ATTN_CH = MIX_WIDTH - CONV_CH
N_Q_HEADS = ATTN_CH // HEAD_DIM
N_KV_HEADS = max(N_Q_HEADS // 4, 1)
KV_CH = N_KV_HEADS * HEAD_DIM
WINDOW = 128
BLOCK = 128
ROPE_THETA = 10000.0
MEM_HEADS = 4
MEM_HEAD_DIM = D_MODEL // MEM_HEADS
D_FF = -(-8 * D_MODEL // (3 * 256)) * 256
IN_COLS = 2 * CONV_CH + ATTN_CH + 2 * KV_CH
EPS = 1e-6

kernel_name = "hybrid_conformer_swa_encoder_block"


def rms_norm(x, g):
    xf = x.astype(jnp.float32)
    y = xf * lax.rsqrt(jnp.mean(xf * xf, axis=-1, keepdims=True) + EPS)
    return (y * g.astype(jnp.float32)).astype(x.dtype)


def layer_norm(x, g, b):
    xf = x.astype(jnp.float32)
    mu = jnp.mean(xf, axis=-1, keepdims=True)
    var = jnp.mean(jnp.square(xf - mu), axis=-1, keepdims=True)
    y = (xf - mu) * lax.rsqrt(var + EPS)
    return (y * g.astype(jnp.float32) + b.astype(jnp.float32)).astype(x.dtype)


def rope_tables(seq):
    pos = jnp.arange(seq, dtype=jnp.float32)
    inv_freq = ROPE_THETA ** (-jnp.arange(0, HEAD_DIM, 2, dtype=jnp.float32) / HEAD_DIM)
    ang = pos[:, None] * inv_freq[None, :]
    return jnp.cos(ang), jnp.sin(ang)


def apply_rope(t, cos, sin):
    t1, t2 = jnp.split(t.astype(jnp.float32), 2, axis=-1)
    c = cos[None, :, None, :]
    s = sin[None, :, None, :]
    return jnp.concatenate([t1 * c - t2 * s, t1 * s + t2 * c], axis=-1).astype(t.dtype)


def conformer_conv_group(u_glu, w_dw, b_dw, ln_g, ln_b):
    a, gate = jnp.split(u_glu, 2, axis=-1)
    v = a * jax.nn.sigmoid(gate)
    y = lax.conv_general_dilated(
        v, w_dw[:, None, :].astype(v.dtype), window_strides=(1,),
        padding=[(CONV_PAD, CONV_PAD)], dimension_numbers=("NWC", "WIO", "NWC"),
        feature_group_count=CONV_CH) + b_dw
    return jax.nn.silu(layer_norm(y, ln_g, ln_b))


def windowed_gqa_with_sink(q, k, v, sink):
    B, S = q.shape[0], q.shape[1]
    nb = S // BLOCK
    G = N_Q_HEADS // N_KV_HEADS
    qb = q.reshape(B, nb, BLOCK, N_KV_HEADS, G, HEAD_DIM)
    pad = ((0, 0), (BLOCK, BLOCK), (0, 0), (0, 0))
    kp = jnp.pad(k, pad).reshape(B, nb + 2, BLOCK, N_KV_HEADS, HEAD_DIM)
    vp = jnp.pad(v, pad).reshape(B, nb + 2, BLOCK, N_KV_HEADS, HEAD_DIM)
    kb = jnp.concatenate([kp[:, :-2], kp[:, 1:-1], kp[:, 2:]], axis=2)
    vb = jnp.concatenate([vp[:, :-2], vp[:, 1:-1], vp[:, 2:]], axis=2)
    a_idx = jnp.arange(BLOCK)[:, None]
    c_idx = jnp.arange(3 * BLOCK)[None, :]
    rel = c_idx - BLOCK - a_idx
    kpos = jnp.arange(nb)[:, None] * BLOCK - BLOCK + jnp.arange(3 * BLOCK)[None, :]
    in_seq = (kpos >= 0) & (kpos < S)
    mask = (jnp.abs(rel) <= WINDOW)[None] & in_seq[:, None, :]
    scale = HEAD_DIM ** -0.5
    s = jnp.einsum("bnqhgd,bnkhd->bnhgqk", qb, kb,
                   preferred_element_type=jnp.float32) * scale
    s = jnp.where(mask[None, :, None, None], s, -jnp.inf)
    sk = sink.astype(jnp.float32).reshape(N_KV_HEADS, G)[None, None, :, :, None, None]
    m = jnp.maximum(jnp.max(s, axis=-1, keepdims=True), sk)
    p = jnp.exp(s - m)
    denom = jnp.sum(p, axis=-1, keepdims=True) + jnp.exp(sk - m)
    o = jnp.einsum("bnhgqk,bnkhd->bnqhgd", (p / denom).astype(v.dtype), vb)
    return o.reshape(B, S, N_Q_HEADS * HEAD_DIM)


def memory_cross_attention(h, mem_n, w_q, w_kv, w_o):
    B, S = h.shape[0], h.shape[1]
    M = mem_n.shape[1]
    q = (h @ w_q).reshape(B, S, MEM_HEADS, MEM_HEAD_DIM)
    km, vm = jnp.split(mem_n @ w_kv, 2, axis=-1)
    km = km.reshape(B, M, MEM_HEADS, MEM_HEAD_DIM)
    vm = vm.reshape(B, M, MEM_HEADS, MEM_HEAD_DIM)
    s = jnp.einsum("bshd,bmhd->bhsm", q, km,
                   preferred_element_type=jnp.float32) * (MEM_HEAD_DIM ** -0.5)
    p = jax.nn.softmax(s, axis=-1)
    o = jnp.einsum("bhsm,bmhd->bshd", p.astype(vm.dtype), vm).reshape(B, S, D_MODEL)
    return o @ w_o


def swiglu(h, w_gate, w_up, w_down):
    return (jax.nn.silu(h @ w_gate) * (h @ w_up)) @ w_down


def setup_inputs(seed: int = 0) -> dict:
    key = jax.random.key(seed)
    ks = jax.random.split(key, 24)
    L = DEPTH

    def nrm(k, shape, scale):
        return jax.random.normal(k, shape, jnp.float32) * scale

    def gain(k, shape):
        return 1.0 + 0.05 * jax.random.normal(k, shape, jnp.float32)

    return {
        "x": nrm(ks[0], (BATCH, SEQ, D_MODEL), 1.0),
        "mem": nrm(ks[1], (BATCH, MEM_LEN, D_MODEL), 1.0),
        "g_mix": gain(ks[2], (L, D_MODEL)),
        "w_in": nrm(ks[3], (L, D_MODEL, IN_COLS), D_MODEL ** -0.5),
        "b_in": nrm(ks[4], (L, IN_COLS), 0.02),
        "w_dw": nrm(ks[5], (L, CONV_WIDTH, CONV_CH), CONV_WIDTH ** -0.5),
        "b_dw": nrm(ks[6], (L, CONV_CH), 0.02),
        "g_conv_ln": gain(ks[7], (L, CONV_CH)),
        "b_conv_ln": nrm(ks[8], (L, CONV_CH), 0.02),
        "attn_sink": nrm(ks[9], (L, N_Q_HEADS), 0.5),
        "w_out": nrm(ks[10], (L, MIX_WIDTH, D_MODEL), MIX_WIDTH ** -0.5),
        "b_out": nrm(ks[11], (L, D_MODEL), 0.02),
        "g_mem_q": gain(ks[12], (L, D_MODEL)),
        "g_mem_kv": gain(ks[13], (L, D_MODEL)),
        "w_mem_q": nrm(ks[14], (L, D_MODEL, D_MODEL), D_MODEL ** -0.5),
        "w_mem_kv": nrm(ks[15], (L, D_MODEL, 2 * D_MODEL), D_MODEL ** -0.5),
        "w_mem_o": nrm(ks[16], (L, D_MODEL, D_MODEL), D_MODEL ** -0.5),
        "g_ffn": gain(ks[17], (L, D_MODEL)),
        "w_gate": nrm(ks[18], (L, D_MODEL, D_FF), D_MODEL ** -0.5),
        "w_up": nrm(ks[19], (L, D_MODEL, D_FF), D_MODEL ** -0.5),
        "w_down": nrm(ks[20], (L, D_FF, D_MODEL), D_FF ** -0.5),
        "g_final": gain(ks[21], (D_MODEL,)),
    }


def reference(x, mem, g_mix, w_in, b_in, w_dw, b_dw, g_conv_ln, b_conv_ln, attn_sink,
              w_out, b_out, g_mem_q, g_mem_kv, w_mem_q, w_mem_kv, w_mem_o,
              g_ffn, w_gate, w_up, w_down, g_final):
    B, S = x.shape[0], x.shape[1]
    cos, sin = rope_tables(S)
    split_pts = [2 * CONV_CH, 2 * CONV_CH + ATTN_CH, 2 * CONV_CH + ATTN_CH + KV_CH]
    for l in range(DEPTH):
        h = rms_norm(x, g_mix[l])
        u = h @ w_in[l] + b_in[l]
        u_glu, q, k, v = jnp.split(u, split_pts, axis=-1)
        y_conv = conformer_conv_group(u_glu, w_dw[l], b_dw[l], g_conv_ln[l], b_conv_ln[l])
        q = apply_rope(q.reshape(B, S, N_Q_HEADS, HEAD_DIM), cos, sin)
        k = apply_rope(k.reshape(B, S, N_KV_HEADS, HEAD_DIM), cos, sin)
        v = v.reshape(B, S, N_KV_HEADS, HEAD_DIM)
        y_attn = windowed_gqa_with_sink(q, k, v, attn_sink[l])
        y_mix = jnp.concatenate([y_conv, y_attn], axis=-1)
        x = x + (y_mix @ w_out[l] + b_out[l])
        x = x + memory_cross_attention(rms_norm(x, g_mem_q[l]), rms_norm(mem, g_mem_kv[l]),
                                       w_mem_q[l], w_mem_kv[l], w_mem_o[l])
        x = x + swiglu(rms_norm(x, g_ffn[l]), w_gate[l], w_up[l], w_down[l])
    return rms_norm(x, g_final)
```

```cpp
#include <hip/hip_runtime.h>
#include <cstdint>
#include <cstdio>

#ifndef MK_N_LAUNCHES
#define MK_N_LAUNCHES 1
#endif

#define LAS __attribute__((address_space(3)))
#define GAS __attribute__((address_space(1)))
typedef unsigned short bf16_t;
typedef short bf16x8 __attribute__((ext_vector_type(8)));
typedef short s16x4 __attribute__((ext_vector_type(4)));
typedef float f32x4 __attribute__((ext_vector_type(4)));
typedef float f32x2 __attribute__((ext_vector_type(2)));
typedef float f32x16 __attribute__((ext_vector_type(16)));
typedef unsigned u32x4 __attribute__((ext_vector_type(4)));
typedef unsigned u32x2 __attribute__((ext_vector_type(2)));

constexpr int D = 1024, BATCH = 8, SEQ = 4096, M = BATCH * SEQ, MEMLEN = 256, MM = BATCH * MEMLEN;
constexpr int CCH = 512, CW = 31, CPAD = 15, HD = 64, NQH = 8, NKVH = 2;
constexpr int IN_COLS = 1792, DFF = 2816, MHD = 256;
constexpr float EPS = 1e-6f;
constexpr float LOG2E = 1.4426950408889634f;
constexpr float QSCALE = 0.125f * LOG2E;
constexpr float MSCALE = 0.0625f * LOG2E;

constexpr size_t MiB = 1u << 20;
constexpr size_t WS_CTL = 0, CTL_ZERO_BYTES = 1 * MiB;
constexpr size_t WS_ROPE = 1 * MiB;
constexpr size_t WS_ST1 = 2 * MiB, WS_ST2 = 4 * MiB, WS_ST3 = 6 * MiB;
constexpr size_t WS_WIN = 8 * MiB;
constexpr size_t WS_WOUT = 12 * MiB;
constexpr size_t WS_WQNB = 14 * MiB;
constexpr size_t WS_WOT = 16 * MiB;
constexpr size_t WS_WKV = 18 * MiB;
constexpr size_t WS_WGU = 22 * MiB;
constexpr size_t WS_WD = 33 * MiB;
constexpr size_t WS_MEMN = 39 * MiB;
constexpr size_t WS_KM = 43 * MiB, WS_VM = 47 * MiB;
constexpr size_t WS_WQK = 51 * MiB;
constexpr size_t WS_VWO = 67 * MiB;
constexpr size_t WS_XB = 84 * MiB;
constexpr size_t WS_X1 = 148 * MiB;
constexpr size_t WS_VGLU = 276 * MiB;
constexpr size_t WS_Q = 308 * MiB;
constexpr size_t WS_K = 340 * MiB;
constexpr size_t WS_VT = 348 * MiB;
constexpr size_t WS_YMIX = 356 * MiB;
constexpr size_t WS_P = 420 * MiB;
constexpr size_t WS_G = 276 * MiB;
constexpr size_t WS_END = 512 * MiB;
static_assert(WS_G + (size_t)M * DFF * 2 <= WS_END && WS_P + (size_t)M * D * 2 <= WS_END, "ws map");
constexpr int CW_TMO = 0, CW_CODE = 1, CW_BAR = 4096;

constexpr int RING_BYTES = 131072;
constexpr int XTAB_OFF = RING_BYTES;
constexpr int MISC_OFF = XTAB_OFF + 8192;
constexpr int LDS_BYTES = 147456;

__device__ __forceinline__ unsigned cvt_pk_bf16(float lo, float hi) { unsigned r; asm volatile("v_cvt_pk_bf16_f32 %0, %1, %2" : "=v"(r) : "v"(lo), "v"(hi)); return r; }
__device__ __forceinline__ float bf16_to_f32(unsigned short b) { return __uint_as_float((unsigned)b << 16); }
__device__ __forceinline__ float sigmoid_fast(float x) { return __builtin_amdgcn_rcpf(1.0f + __builtin_amdgcn_exp2f(-x * LOG2E)); }
__device__ __forceinline__ float wave_sum(float v) {
#pragma unroll
    for (int o = 1; o < 64; o <<= 1) v += __shfl_xor(v, o);
    return v;
}
__device__ __forceinline__ int tid_now(int wave_s) { int l = (int)__builtin_amdgcn_mbcnt_hi(~0u, __builtin_amdgcn_mbcnt_lo(~0u, 0u)); asm volatile("" : "+v"(l)); return wave_s * 64 + l; }
#define LDS_WAIT() asm volatile("s_waitcnt lgkmcnt(0)" ::: "memory")
#define VM_WAIT() asm volatile("s_waitcnt vmcnt(0)" ::: "memory")

namespace pg8 {
constexpr int BM = 256, BK = 64, HALF = 128, HTB = HALF * BK * 2, NXCD = 8, WGM = 8;
__host__ __device__ __forceinline__ int lds_byte(int r, int c) { const int st = (r >> 4) * 2 + (c >> 5), rr = r & 15, cc = c & 31, ob = rr * 64 + cc * 2; return st * 1024 + (ob ^ (((ob >> 9) & 1) << 5)); }
__host__ __device__ __forceinline__ void stage_rc(int b, int& R, int& C) { const int st = b / 1024, sb = b % 1024, swz = sb ^ (((sb >> 9) & 1) << 5); R = (st >> 1) * 16 + swz / 64; C = (st & 1) * 32 + (swz % 64) / 2; }
__host__ __device__ __forceinline__ int perm32(int rho) { const int n = rho >> 4, i = rho & 15; return 8 * (i >> 2) + 4 * n + (i & 3); }

struct Unit { int pm, pn; unsigned aoff, boff, ooff; };
struct Gemm { const bf16_t* A; const bf16_t* Bt; int lda, ldb, K; };

struct StaticOrder {
    int nM, nN, nwg, G, c, lda, ldb, pm_per_b; size_t bstride;
    __device__ void init(int Mr, int N, int G_, int c_, int lda_, int ldb_, int pmpb = 0, size_t bstr = 0) { nM = Mr / BM; nN = N / BM; nwg = nM * nN; G = G_; c = c_; lda = lda_; ldb = ldb_; pm_per_b = pmpb; bstride = bstr; }
    __device__ bool next(int i, Unit& u) const {
        const long L = (long)i * G + c; if (L >= nwg) return false;
        int wgid = (int)L; { const int q = nwg / NXCD, r = nwg % NXCD, xcd = wgid % NXCD, off = wgid / NXCD; wgid = (xcd < r ? xcd * (q + 1) : r * (q + 1) + (xcd - r) * q) + off; }
        const int nig = WGM * nN, gid = wgid / nig, fm = gid * WGM, gsz = (nM - fm) < WGM ? (nM - fm) : WGM;
        u.pm = fm + ((wgid % nig) % gsz); u.pn = (wgid % nig) / gsz;
        u.aoff = (unsigned)(u.pm * BM * lda); u.boff = (unsigned)(u.pn * BM * ldb) + (pm_per_b ? (unsigned)(u.pm / pm_per_b) * (unsigned)bstride : 0u); u.ooff = 0u;
        return true;
    }
};
struct SmallOrder {
    int c, G;
    __device__ bool next(int i, Unit& u) const {
        const int L = i * G + c; if (L >= 256) return false;
        const int kind = L >> 7, z = (L & 127) >> 2, sub = L & 3, b = z >> 2, h = z & 3;
        if (kind == 0) { u.pm = 0; u.pn = sub; u.aoff = (unsigned)(WS_KM / 2) + (unsigned)(b * 256) * 1024u + h * 256; u.boff = (unsigned)(WS_WQNB / 2) + (unsigned)(sub * 256) * 1024u + h * 256; u.ooff = (unsigned)(WS_WQK / 2) + (unsigned)b * 1048576u + (unsigned)(h * 256) * 1024u; }
        else { u.pm = sub; u.pn = 0; u.aoff = (unsigned)(WS_WOT / 2) + (unsigned)(sub * 256) * 1024u + h * 256; u.boff = (unsigned)(WS_VM / 2) + (unsigned)(b * 256) * 1024u + h * 256; u.ooff = (unsigned)(WS_VWO / 2) + (unsigned)b * 1048576u + h * 256; }
        return true;
    }
};

template <class Epi, class Sched, bool ALIGN_EPI>
__device__ __forceinline__ void gemm_phase(LAS unsigned char* lds, const Gemm g, const Sched& S, const Epi& E, int wave_s) {
    const int tid = tid_now(wave_s), wid = wave_s, lane = tid & 63, wr = wid >> 2, wc = wid & 3, fr = lane & 15, fq = lane >> 4;
    const int K = g.K, nt = K / BK;
    unsigned voffA[2], voffB[2];
#pragma unroll
    for (int i = 0; i < 2; ++i) { int R, C; stage_rc(tid * 16 + i * 8192, R, C); const int Rb = Epi::PERM ? ((R & ~31) + perm32(R & 31)) : R;
        voffA[i] = (unsigned)(R * g.lda + C) * 2u; voffB[i] = (unsigned)(Rb * g.ldb + C) * 2u; }
    const size_t kstep = (size_t)(BK * 2);
    const size_t hstepA = (size_t)HALF * g.lda * 2, hstepB = (size_t)HALF * g.ldb * 2;
    const unsigned ldsw = (unsigned)wid * 1024u;
    const int aoff = lds_byte(wr * 64 + fr, fq * 8), boff = lds_byte(wc * 32 + fr, fq * 8);
#define PG8_SA(b, h) (((b) * 2 + (h)) * HTB)
#define PG8_SB(b, h) ((4 + (b) * 2 + (h)) * HTB)
#define PG8_STAGE(bufoff, gbase, voff) do { _Pragma("unroll") for (int _i = 0; _i < 2; ++_i) \
        __builtin_amdgcn_global_load_lds((const unsigned*)((const char*)(gbase) + (voff)[_i]), (LAS unsigned*)(lds + (bufoff) + ldsw + _i * 8192), 16, 0, 0); } while (0)
#define PG8_LDA(dst, b, h) do { _Pragma("unroll") for (int m = 0; m < 4; ++m) _Pragma("unroll") for (int k = 0; k < 2; ++k) dst[m][k] = *(const LAS bf16x8*)(lds + PG8_SA(b, h) + aoff + m * 2048 + k * 1024); } while (0)
#define PG8_LDB(dst, b, h) do { _Pragma("unroll") for (int n = 0; n < 2; ++n) _Pragma("unroll") for (int k = 0; k < 2; ++k) dst[n][k] = *(const LAS bf16x8*)(lds + PG8_SB(b, h) + boff + n * 2048 + k * 1024); } while (0)
#define PG8_MMA(ai, bj, At, Bt) do { __builtin_amdgcn_s_setprio(1); _Pragma("unroll") for (int m = 0; m < 4; ++m) _Pragma("unroll") for (int n = 0; n < 2; ++n) _Pragma("unroll") for (int k = 0; k < 2; ++k) \
        acc[ai][bj][m][n] = __builtin_amdgcn_mfma_f32_16x16x32_bf16(Bt[n][k], At[m][k], acc[ai][bj][m][n], 0, 0, 0); __builtin_amdgcn_s_setprio(0); } while (0)
#define PG8_WAIT_V(n) asm volatile("s_waitcnt vmcnt(" #n ")" ::: "memory")
#define PG8_WAIT_L(n) asm volatile("s_waitcnt lgkmcnt(" #n ")" ::: "memory")
#define PG8_BAR __builtin_amdgcn_s_barrier()
#define PG8_SCHED __builtin_amdgcn_sched_barrier(0)
    Unit cur, nxt; int ui = 0;
    if (!S.next(0, cur)) return;
    f32x4 acc[2][2][4][2];
#pragma unroll
    for (int a = 0; a < 2; ++a)
#pragma unroll
        for (int b = 0; b < 2; ++b)
#pragma unroll
            for (int m = 0; m < 4; ++m)
#pragma unroll
                for (int n = 0; n < 2; ++n) acc[a][b][m][n] = (f32x4){0.f, 0.f, 0.f, 0.f};
    bf16x8 At[4][2], B0[2][2], B1[2][2];
    const char* cA = (const char*)(g.A + cur.aoff); const char* cB = (const char*)(g.Bt + cur.boff);
    PG8_STAGE(PG8_SB(0, 0), cB, voffB); PG8_STAGE(PG8_SB(0, 1), cB + hstepB, voffB); PG8_STAGE(PG8_SA(0, 0), cA, voffA); PG8_STAGE(PG8_SA(0, 1), cA + hstepA, voffA);
    if (wr == 1) PG8_BAR;
    PG8_WAIT_V(2); PG8_BAR;
    PG8_STAGE(PG8_SB(1, 0), cB + kstep, voffB); PG8_STAGE(PG8_SA(1, 0), cA + kstep, voffA); PG8_STAGE(PG8_SB(1, 1), cB + hstepB + kstep, voffB);
    PG8_WAIT_V(6); PG8_BAR;
    for (;;) {
        const bool has_next = S.next(ui + 1, nxt);
        const char* nA = has_next ? (const char*)(g.A + nxt.aoff) : cA; const char* nB = has_next ? (const char*)(g.Bt + nxt.boff) : cB;
        for (int t = 0; t < nt; t += 2) {
            const bool last = (t == nt - 2);
            const char* a1 = cA + (size_t)(t + 1) * kstep;
            const char* a2 = last ? nA : cA + (size_t)(t + 2) * kstep; const char* b2 = last ? nB : cB + (size_t)(t + 2) * kstep;
            const char* a3 = a2 + kstep; const char* b3 = b2 + kstep;
            PG8_LDB(B0, 0, 0); PG8_LDB(B1, 0, 1); PG8_SCHED; PG8_LDA(At, 0, 0); PG8_STAGE(PG8_SA(1, 1), a1 + hstepA, voffA);
            PG8_WAIT_V(8); PG8_WAIT_L(0); PG8_BAR; PG8_MMA(0, 0, At, B0); PG8_MMA(0, 1, At, B1); PG8_BAR; PG8_SCHED;
            PG8_LDA(At, 0, 1); PG8_STAGE(PG8_SB(0, 0), b2, voffB); PG8_STAGE(PG8_SB(0, 1), b2 + hstepB, voffB); PG8_STAGE(PG8_SA(0, 0), a2, voffA);
            PG8_WAIT_V(8); PG8_WAIT_L(0); PG8_BAR; PG8_MMA(1, 0, At, B0); PG8_MMA(1, 1, At, B1); PG8_BAR; PG8_SCHED;
            PG8_LDB(B0, 1, 0); PG8_LDB(B1, 1, 1); PG8_SCHED; PG8_LDA(At, 1, 0); PG8_STAGE(PG8_SA(0, 1), a2 + hstepA, voffA);
            PG8_WAIT_V(8); PG8_WAIT_L(0); PG8_BAR; PG8_MMA(0, 0, At, B0); PG8_MMA(0, 1, At, B1); PG8_BAR; PG8_SCHED;
            PG8_LDA(At, 1, 1); PG8_STAGE(PG8_SB(1, 0), b3, voffB); PG8_STAGE(PG8_SB(1, 1), b3 + hstepB, voffB); PG8_STAGE(PG8_SA(1, 0), a3, voffA);
            PG8_WAIT_V(8); PG8_WAIT_L(0); PG8_BAR; PG8_MMA(1, 0, At, B0); PG8_MMA(1, 1, At, B1); PG8_BAR; PG8_SCHED;
        }
        if constexpr (ALIGN_EPI) { if (wr == 0) PG8_BAR; }
        { int l2 = lane; asm volatile("" : "+v"(l2)); E(acc, cur, wr, wc, l2 & 15, l2 >> 4); }
        if (!has_next) break;
#pragma unroll
        for (int a = 0; a < 2; ++a)
#pragma unroll
            for (int b = 0; b < 2; ++b)
#pragma unroll
                for (int m = 0; m < 4; ++m)
#pragma unroll
                    for (int n = 0; n < 2; ++n) acc[a][b][m][n] = (f32x4){0.f, 0.f, 0.f, 0.f};
        cur = nxt; cA = nA; cB = nB; ++ui;
        if constexpr (ALIGN_EPI) { if (wr == 1) PG8_BAR; }
    }
    PG8_WAIT_V(0);
    if constexpr (!ALIGN_EPI) { if (wr == 0) PG8_BAR; }
    PG8_BAR;
#undef PG8_SA
#undef PG8_SB
#undef PG8_STAGE
#undef PG8_LDA
#undef PG8_LDB
#undef PG8_MMA
#undef PG8_WAIT_V
#undef PG8_WAIT_L
#undef PG8_BAR
#undef PG8_SCHED
}

typedef f32x4 (&AccRef)[2][2][4][2];

struct EpiBf16 {
    static constexpr bool PERM = true;
    bf16_t* O; int ldc;
    __device__ __forceinline__ void operator()(AccRef acc, const Unit& u, int wr, int wc, int fr, int fq) const {
        bf16_t* base = O + u.ooff + (size_t)(u.pm * BM + wr * 64 + fr) * ldc + u.pn * BM + wc * 32 + 8 * fq;
#pragma unroll
        for (int ai = 0; ai < 2; ++ai)
#pragma unroll
            for (int m = 0; m < 4; ++m) { bf16_t* rowp = base + (size_t)(ai * HALF + m * 16) * ldc;
#pragma unroll
                for (int bj = 0; bj < 2; ++bj) { const f32x4 v0 = acc[ai][bj][m][0], v1 = acc[ai][bj][m][1];
                    u32x4 w; w.x = cvt_pk_bf16(v0[0], v0[1]); w.y = cvt_pk_bf16(v0[2], v0[3]); w.z = cvt_pk_bf16(v1[0], v1[1]); w.w = cvt_pk_bf16(v1[2], v1[3]);
                    *(u32x4*)(rowp + bj * HALF) = w; } }
    }
};
struct EpiKV {
    static constexpr bool PERM = true;
    bf16_t* KMp; bf16_t* VMp;
    __device__ __forceinline__ void operator()(AccRef acc, const Unit& u, int wr, int wc, int fr, int fq) const {
        bf16_t* O = (u.pn < 4) ? KMp : VMp; const int colt = (u.pn & 3) * BM;
        bf16_t* base = O + (size_t)(u.pm * BM + wr * 64 + fr) * 1024 + colt + wc * 32 + 8 * fq;
#pragma unroll
        for (int ai = 0; ai < 2; ++ai)
#pragma unroll
            for (int m = 0; m < 4; ++m) { bf16_t* rowp = base + (size_t)(ai * HALF + m * 16) * 1024;
#pragma unroll
                for (int bj = 0; bj < 2; ++bj) { const f32x4 v0 = acc[ai][bj][m][0], v1 = acc[ai][bj][m][1];
                    u32x4 w; w.x = cvt_pk_bf16(v0[0], v0[1]); w.y = cvt_pk_bf16(v0[2], v0[3]); w.z = cvt_pk_bf16(v1[0], v1[1]); w.w = cvt_pk_bf16(v1[2], v1[3]);
                    *(u32x4*)(rowp + bj * HALF) = w; } }
    }
};
struct EpiIn {
    static constexpr bool PERM = true;
    const float* b_in; const float* rope; bf16_t* VGLU; bf16_t* Q; bf16_t* Kb; bf16_t* VT;
    __device__ __forceinline__ void operator()(AccRef acc, const Unit& u, int wr, int wc, int fr, int fq) const {
        const int row0 = u.pm * BM + wr * 64 + fr;
        if (u.pn < 4) {
            const int ch = u.pn * 128 + wc * 32 + 8 * fq;
            f32x4 ba[2], bg[2];
#pragma unroll
            for (int n = 0; n < 2; ++n) { ba[n] = *(const f32x4*)(b_in + ch + 4 * n); bg[n] = *(const f32x4*)(b_in + 512 + ch + 4 * n); }
#pragma unroll
            for (int ai = 0; ai < 2; ++ai)
#pragma unroll
                for (int m = 0; m < 4; ++m) { const int row = row0 + ai * HALF + m * 16; float v[8];
#pragma unroll
                    for (int n = 0; n < 2; ++n) { const f32x4 a = acc[ai][0][m][n] + ba[n], gt = acc[ai][1][m][n] + bg[n];
#pragma unroll
                        for (int j = 0; j < 4; ++j) v[4 * n + j] = a[j] * sigmoid_fast(gt[j]); }
                    u32x4 w; w.x = cvt_pk_bf16(v[0], v[1]); w.y = cvt_pk_bf16(v[2], v[3]); w.z = cvt_pk_bf16(v[4], v[5]); w.w = cvt_pk_bf16(v[6], v[7]);
                    *(u32x4*)(VGLU + (size_t)row * CCH + ch) = w; }
        } else if (u.pn < 6 || wc < 2) {
            const bool isq = u.pn < 6; const int head = isq ? (u.pn - 4) * 4 + wc : wc; const int d = 8 * fq;
            const int bcol = (isq ? 1024 : 1536) + head * 64 + d; const float sc = isq ? QSCALE : 1.0f;
            f32x4 b1[2], b2[2];
#pragma unroll
            for (int n = 0; n < 2; ++n) { b1[n] = *(const f32x4*)(b_in + bcol + 4 * n); b2[n] = *(const f32x4*)(b_in + bcol + 32 + 4 * n); }
#pragma unroll
            for (int ai = 0; ai < 2; ++ai)
#pragma unroll
                for (int m = 0; m < 4; ++m) { const int row = row0 + ai * HALF + m * 16; const int pos = row & (SEQ - 1);
                    const f32x4* cs = (const f32x4*)(rope + ((size_t)pos * 32 + d) * 2); float o1[8], o2[8];
#pragma unroll
                    for (int n = 0; n < 2; ++n) { const f32x4 t1 = acc[ai][0][m][n] + b1[n], t2 = acc[ai][1][m][n] + b2[n]; const f32x4 cA = cs[2 * n], cB = cs[2 * n + 1];
                        const float c[4] = {cA[0], cA[2], cB[0], cB[2]}, s[4] = {cA[1], cA[3], cB[1], cB[3]};
#pragma unroll
                        for (int j = 0; j < 4; ++j) { o1[4 * n + j] = (t1[j] * c[j] - t2[j] * s[j]) * sc; o2[4 * n + j] = (t1[j] * s[j] + t2[j] * c[j]) * sc; } }
                    u32x4 w1, w2; w1.x = cvt_pk_bf16(o1[0], o1[1]); w1.y = cvt_pk_bf16(o1[2], o1[3]); w1.z = cvt_pk_bf16(o1[4], o1[5]); w1.w = cvt_pk_bf16(o1[6], o1[7]);
                    w2.x = cvt_pk_bf16(o2[0], o2[1]); w2.y = cvt_pk_bf16(o2[2], o2[3]); w2.z = cvt_pk_bf16(o2[4], o2[5]); w2.w = cvt_pk_bf16(o2[6], o2[7]);
                    bf16_t* dst = isq ? (Q + (size_t)row * 512 + head * 64 + d) : (Kb + ((size_t)((row >> 12) * 2 + head) * SEQ + pos) * 64 + d);
                    *(u32x4*)dst = w1; *(u32x4*)(dst + 32) = w2; }
        } else {
            const int d0 = (wc - 2) * 32 + 8 * fq;
#pragma unroll
            for (int bj = 0; bj < 2; ++bj) { f32x4 bv[2];
#pragma unroll
                for (int n = 0; n < 2; ++n) bv[n] = *(const f32x4*)(b_in + 1664 + bj * 64 + d0 + 4 * n);
#pragma unroll
                for (int ai = 0; ai < 2; ++ai)
#pragma unroll
                    for (int m = 0; m < 4; ++m) { const int row = row0 + ai * HALF + m * 16; const int pos = row & (SEQ - 1);
                        bf16_t* dst = VT + ((size_t)((row >> 12) * 2 + bj) * 64 + d0) * SEQ + pos;
#pragma unroll
                        for (int n = 0; n < 2; ++n) { const f32x4 v = acc[ai][bj][m][n] + bv[n];
#pragma unroll
                            for (int j = 0; j < 4; j += 2) { const unsigned w = cvt_pk_bf16(v[j], v[j + 1]); dst[(size_t)(4 * n + j) * SEQ] = (bf16_t)(w & 0xffffu); dst[(size_t)(4 * n + j + 1) * SEQ] = (bf16_t)(w >> 16); } } }
            }
        }
    }
};
struct EpiRes {
    static constexpr bool PERM = false;
    const float* base; float* OUT; bf16_t* XB; const float* bias; float* ST;
    __device__ __forceinline__ void operator()(AccRef acc, const Unit& u, int wr, int wc, int fr, int fq) const {
        const int row0 = u.pm * BM + wr * 64 + fr, col0 = u.pn * BM + wc * 32 + 4 * fq;
        f32x4 bv[2][2];
#pragma unroll
        for (int bj = 0; bj < 2; ++bj)
#pragma unroll
            for (int n = 0; n < 2; ++n) bv[bj][n] = bias ? *(const f32x4*)(bias + col0 + bj * HALF + n * 16) : (f32x4){0.f, 0.f, 0.f, 0.f};
#pragma unroll
        for (int ai = 0; ai < 2; ++ai)
#pragma unroll
            for (int m = 0; m < 4; ++m) { const int row = row0 + ai * HALF + m * 16; const size_t off = (size_t)row * D + col0; float ss = 0.f;
#pragma unroll
                for (int bj = 0; bj < 2; ++bj)
#pragma unroll
                    for (int n = 0; n < 2; ++n) { const f32x4 o = *(const f32x4*)(base + off + bj * HALF + n * 16) + acc[ai][bj][m][n] + bv[bj][n];
                        *(f32x4*)(OUT + off + bj * HALF + n * 16) = o; ss += (o[0] * o[0] + o[1] * o[1]) + (o[2] * o[2] + o[3] * o[3]);
                        if (XB) { u32x2 w; w.x = cvt_pk_bf16(o[0], o[1]); w.y = cvt_pk_bf16(o[2], o[3]); *(u32x2*)(XB + off + bj * HALF + n * 16) = w; } }
                ss += __shfl_xor(ss, 16); ss += __shfl_xor(ss, 32);
                if (fq == 0) ST[(size_t)row * 16 + u.pn * 4 + wc] = ss; }
    }
};
__device__ __forceinline__ float row_rs(const float* ST, int row) {
    const f32x4* p = (const f32x4*)(ST + (size_t)row * 16); const f32x4 a = p[0], b = p[1], c = p[2], d = p[3];
    const float s = ((a[0] + a[1]) + (a[2] + a[3])) + ((b[0] + b[1]) + (b[2] + b[3])) + ((c[0] + c[1]) + (c[2] + c[3])) + ((d[0] + d[1]) + (d[2] + d[3]));
    return rsqrtf(s * (1.0f / D) + EPS);
}
struct EpiSoftmax {
    static constexpr bool PERM = true;
    const float* ST; bf16_t* P; LAS f32x2* tab;
    __device__ __forceinline__ void operator()(f32x4 (&acc)[2][2][4][2], const Unit& u, int wr, int wc, int fr, int fq) const {
        const int row0 = u.pm * BM + wr * 64 + fr; float mloc[8];
#pragma unroll
        for (int ai = 0; ai < 2; ++ai)
#pragma unroll
            for (int m = 0; m < 4; ++m) { const int q = ai * 4 + m; const int row = row0 + ai * HALF + m * 16; const float sc = row_rs(ST, row) * MSCALE; float mx = -INFINITY;
#pragma unroll
                for (int bj = 0; bj < 2; ++bj)
#pragma unroll
                    for (int n = 0; n < 2; ++n) { acc[ai][bj][m][n] = acc[ai][bj][m][n] * sc; const f32x4 s = acc[ai][bj][m][n]; mx = fmaxf(mx, fmaxf(fmaxf(s[0], s[1]), fmaxf(s[2], s[3]))); }
                mx = fmaxf(mx, __shfl_xor(mx, 16)); mx = fmaxf(mx, __shfl_xor(mx, 32)); mloc[q] = mx; float sum = 0.f;
#pragma unroll
                for (int bj = 0; bj < 2; ++bj)
#pragma unroll
                    for (int n = 0; n < 2; ++n) { f32x4 s = acc[ai][bj][m][n];
#pragma unroll
                        for (int j = 0; j < 4; ++j) { s[j] = __builtin_amdgcn_exp2f(s[j] - mx); sum += s[j]; }
                        acc[ai][bj][m][n] = s; }
                sum += __shfl_xor(sum, 16); sum += __shfl_xor(sum, 32);
                if (fq == 0) tab[(ai * HALF + wr * 64 + m * 16 + fr) * 4 + wc] = (f32x2){mx, sum}; }
        LDS_WAIT(); __builtin_amdgcn_s_barrier(); asm volatile("" ::: "memory");
#pragma unroll
        for (int ai = 0; ai < 2; ++ai)
#pragma unroll
            for (int m = 0; m < 4; ++m) { const int q = ai * 4 + m; const int lr = ai * HALF + wr * 64 + m * 16 + fr; const int row = u.pm * BM + lr;
                const f32x2 t0 = tab[lr * 4 + 0], t1 = tab[lr * 4 + 1], t2 = tab[lr * 4 + 2], t3 = tab[lr * 4 + 3];
                const float mg = fmaxf(fmaxf(t0.x, t1.x), fmaxf(t2.x, t3.x));
                const float L = t0.y * __builtin_amdgcn_exp2f(t0.x - mg) + t1.y * __builtin_amdgcn_exp2f(t1.x - mg) + t2.y * __builtin_amdgcn_exp2f(t2.x - mg) + t3.y * __builtin_amdgcn_exp2f(t3.x - mg);
                const float f = __builtin_amdgcn_exp2f(mloc[q] - mg) * __builtin_amdgcn_rcpf(L);
                bf16_t* rowp = P + (size_t)row * D + u.pn * BM + wc * 32 + 8 * fq;
#pragma unroll
                for (int bj = 0; bj < 2; ++bj) { const f32x4 v0 = acc[ai][bj][m][0] * f, v1 = acc[ai][bj][m][1] * f;
                    u32x4 w; w.x = cvt_pk_bf16(v0[0], v0[1]); w.y = cvt_pk_bf16(v0[2], v0[3]); w.z = cvt_pk_bf16(v1[0], v1[1]); w.w = cvt_pk_bf16(v1[2], v1[3]);
                    *(u32x4*)(rowp + bj * HALF) = w; } }
    }
};
struct EpiSwiglu {
    static constexpr bool PERM = true;
    const float* ST; bf16_t* G;
    __device__ __forceinline__ void operator()(AccRef acc, const Unit& u, int wr, int wc, int fr, int fq) const {
        const int row0 = u.pm * BM + wr * 64 + fr; const int col = u.pn * 128 + wc * 32 + 8 * fq;
#pragma unroll
        for (int ai = 0; ai < 2; ++ai)
#pragma unroll
            for (int m = 0; m < 4; ++m) { const int row = row0 + ai * HALF + m * 16; const float rs = row_rs(ST, row); float v[8];
#pragma unroll
                for (int n = 0; n < 2; ++n)
#pragma unroll
                    for (int j = 0; j < 4; ++j) { const float gt = acc[ai][0][m][n][j] * rs, up = acc[ai][1][m][n][j] * rs; v[4 * n + j] = gt * sigmoid_fast(gt) * up; }
                u32x4 w; w.x = cvt_pk_bf16(v[0], v[1]); w.y = cvt_pk_bf16(v[2], v[3]); w.z = cvt_pk_bf16(v[4], v[5]); w.w = cvt_pk_bf16(v[6], v[7]);
                *(u32x4*)(G + (size_t)row * DFF + col) = w; }
    }
};
}

typedef GAS unsigned gu32;
#define RLX_AGENT __ATOMIC_RELAXED, __HIP_MEMORY_SCOPE_AGENT
#define XB_TMO      128
#define XB_XCNT(j)  (256  + 64 * (j))
#define XB_XSUB(j)  (1280 + 64 * (j))
#define XB_XGEN(j)  (2304 + 64 * (j))
#define XB_TOP      3328
#define XB_TOPGEN   3392
#define XCD_BAR_WORDS 3456
#define XB_SPIN_CAP (1u << 18)
__device__ __forceinline__ unsigned xb_ld(unsigned* p)              { return __hip_atomic_load(p, __ATOMIC_RELAXED, __HIP_MEMORY_SCOPE_AGENT); }
__device__ __forceinline__ unsigned xb_add(unsigned* p, unsigned v) { return __hip_atomic_fetch_add(p, v, __ATOMIC_RELAXED, __HIP_MEMORY_SCOPE_AGENT); }
__device__ __forceinline__ unsigned xb_xcc_id() { return (unsigned)__builtin_amdgcn_s_getreg((3 << 11) | 20) & 0xFu; }
#define XB_SPIN(cond, bar) do { unsigned _sp = 0; while (cond) { __builtin_amdgcn_s_sleep(1); \
    if ((++_sp & 255u) == 0u) { if (xb_ld(&(bar)[XB_TMO])) break; if (_sp > XB_SPIN_CAP) { atomicAdd(&(bar)[XB_TMO], 1u); break; } } } } while (0)
struct XcdBarrier { unsigned* bar; unsigned x; volatile LAS unsigned* st; };
__device__ __forceinline__ XcdBarrier xcd_barrier_post(unsigned* bar, volatile LAS unsigned* st, int tid) {
    XcdBarrier b; b.bar = bar; b.x = xb_xcc_id(); b.st = st;
    if (tid == 0) (void)xb_add(&bar[XB_XCNT(b.x)], 1u);
    return b;
}
__device__ __forceinline__ void xcd_barrier_complete(unsigned* bar, unsigned x, unsigned& nloc, unsigned& nx) {
    const unsigned G = gridDim.x * gridDim.y * gridDim.z;
    unsigned sum, cnt, mine, sp = 0u;
    for (;;) {
        sum = 0u; cnt = 0u; mine = 0u;
#pragma unroll
        for (unsigned j = 0; j < 16; ++j) { const unsigned c = xb_ld(&bar[XB_XCNT(j)]); sum += c; cnt += (c > 0u) ? 1u : 0u; mine = (j == x) ? c : mine; }
        if (sum == G) break;
        __builtin_amdgcn_s_sleep(1);
        if ((++sp & 255u) == 0u) { if (xb_ld(&bar[XB_TMO])) break; if (sp > XB_SPIN_CAP) { atomicAdd(&bar[XB_TMO], 1u); break; } }
    }
    nloc = mine > 0u ? mine : 1u; nx = cnt > 0u ? cnt : 1u;
}
__device__ __forceinline__ void xcd_barrier(const XcdBarrier& b, int tid) {
    asm volatile("s_waitcnt vmcnt(0)" ::: "memory");
    __syncthreads();
    if (tid == 0) {
        unsigned* bar = b.bar;
        __builtin_amdgcn_s_waitcnt(0);
        unsigned nloc = b.st[0], nx = b.st[1];
        if (nloc == 0u) { xcd_barrier_complete(bar, b.x, nloc, nx); b.st[0] = nloc; b.st[1] = nx; }
        const unsigned old = xb_add(&bar[XB_XSUB(b.x)], 1u);
        const unsigned gen = old / nloc;
        if (old + 1u == (gen + 1u) * nloc) {
            __builtin_amdgcn_fence(__ATOMIC_RELEASE, "agent");
            asm volatile("s_waitcnt vmcnt(0)" ::: "memory");
            const unsigned og = xb_add(&bar[XB_TOP], 1u);
            const unsigned tg = og / nx;
            if (og + 1u == (tg + 1u) * nx) xb_add(&bar[XB_TOPGEN], 1u);
            else XB_SPIN(xb_ld(&bar[XB_TOPGEN]) == tg, bar);
            __builtin_amdgcn_fence(__ATOMIC_ACQUIRE, "agent");
            xb_add(&bar[XB_XGEN(b.x)], 1u);
            asm volatile("s_waitcnt vmcnt(0)" ::: "memory");
        } else {
            XB_SPIN(xb_ld(&bar[XB_XGEN(b.x)]) == gen, bar);
            __builtin_amdgcn_fence(__ATOMIC_ACQUIRE, "agent");
            asm volatile("s_waitcnt vmcnt(0)" ::: "memory");
        }
    }
    __syncthreads();
}

constexpr int NWAVES = 8;
struct Args { const float* in[22]; float* out; unsigned char* ws; int ph_lo, ph_hi, li, pad; };
struct Frame { LAS unsigned char* lds; int tid, lane, wave, vcu, G; };

__device__ __forceinline__ unsigned f2bf(float f) { unsigned u = __builtin_bit_cast(unsigned, f); return (u + 0x7fffu + ((u >> 16) & 1u)) >> 16; }
__device__ __forceinline__ unsigned pk2(float lo, float hi) { return f2bf(lo) | (f2bf(hi) << 16); }
__device__ __forceinline__ void p0_transpose_item(const float* W, int K, int N, int src_col0, int kb, bf16_t* WT, int dst_row0, const float* g, LAS float* scr, int lane) {
    const int k0 = 64 * kb;
#pragma unroll 8
    for (int i = 0; i < 32; ++i) { const int kk = 2 * i + (lane >> 5); float v = W[(size_t)(k0 + kk) * N + src_col0 + (lane & 31)]; if (g) v *= g[k0 + kk]; scr[kk * 33 + (lane & 31)] = v; }
    LDS_WAIT(); asm volatile("" ::: "memory");
    const int c = lane & 7;
#pragma unroll
    for (int j = 0; j < 4; ++j) { const int n = (lane >> 3) + 8 * j; const LAS float* s = scr + (8 * c) * 33 + n;
        u32x4 o; o.x = pk2(s[0 * 33], s[1 * 33]); o.y = pk2(s[2 * 33], s[3 * 33]); o.z = pk2(s[4 * 33], s[5 * 33]); o.w = pk2(s[6 * 33], s[7 * 33]);
        *(GAS u32x4*)(WT + (size_t)(dst_row0 + n) * K + k0 + 8 * c) = o; }
    LDS_WAIT(); asm volatile("" ::: "memory");
}
__device__ __forceinline__ int win_src_col(int gi) {
    const int tile = gi >> 3, bj = (gi >> 2) & 1, wc = gi & 3;
    if (tile < 4) return bj * 512 + tile * 128 + wc * 32;
    if (tile < 6) return 1024 + ((tile - 4) * 4 + wc) * 64 + bj * 32;
    if (wc < 2) return 1536 + wc * 64 + bj * 32;
    return 1664 + bj * 64 + (wc - 2) * 32;
}
__device__ __forceinline__ void rms_row_to_bf16(const float* xrow, const float* g, bf16_t* orow, int lane) {
    const GAS f32x4* xr = (const GAS f32x4*)xrow + lane; const GAS f32x4* gr = (const GAS f32x4*)g + lane;
    f32x4 v[4]; float s = 0.f;
#pragma unroll
    for (int j = 0; j < 4; ++j) { v[j] = xr[64 * j]; s += (v[j].x * v[j].x + v[j].y * v[j].y) + (v[j].z * v[j].z + v[j].w * v[j].w); }
    const float r = rsqrtf(wave_sum(s) * (1.f / D) + EPS);
    GAS unsigned long long* o8 = (GAS unsigned long long*)orow + lane;
#pragma unroll
    for (int j = 0; j < 4; ++j) { const f32x4 gv = gr[64 * j]; o8[64 * j] = (unsigned long long)pk2(v[j].x * r * gv.x, v[j].y * r * gv.y) | ((unsigned long long)pk2(v[j].z * r * gv.z, v[j].w * r * gv.w) << 32); }
}

__device__ __forceinline__ void p0_prologue(const Frame& F, const Args& a) {
    unsigned char* ws = a.ws;
    LAS float* scr = (LAS float*)(F.lds + F.wave * 16384);
    const int gw = F.vcu * NWAVES + F.wave, NGW = F.G * NWAVES;
    const float* w_in = a.in[3]; const float* w_out = a.in[10]; const float* w_mq = a.in[14]; const float* w_mkv = a.in[15]; const float* w_mo = a.in[16];
    const float* w_gate = a.in[18]; const float* w_up = a.in[19]; const float* w_down = a.in[20];
    constexpr int I_IN = 56 * 16, I_OUT = 32 * 16, I_MO = 32 * 16, I_KV = 64 * 16, I_GU = 176 * 16, I_D = 32 * 44;
    constexpr int NIT = I_IN + I_OUT + I_MO + I_KV + I_GU + I_D;
    for (int it = gw; it < NIT; it += NGW) {
        int r = it;
        if (r < I_IN) { const int gi = r >> 4, kb = r & 15; p0_transpose_item(w_in, D, IN_COLS, win_src_col(gi), kb, (bf16_t*)(ws + WS_WIN), gi * 32, nullptr, scr, F.lane); continue; } r -= I_IN;
        if (r < I_OUT) { const int gi = r >> 4, kb = r & 15; p0_transpose_item(w_out, D, D, gi * 32, kb, (bf16_t*)(ws + WS_WOUT), gi * 32, nullptr, scr, F.lane); continue; } r -= I_OUT;
        if (r < I_MO) { const int gi = r >> 4, kb = r & 15; p0_transpose_item(w_mo, D, D, gi * 32, kb, (bf16_t*)(ws + WS_WOT), gi * 32, nullptr, scr, F.lane); continue; } r -= I_MO;
        if (r < I_KV) { const int gi = r >> 4, kb = r & 15; p0_transpose_item(w_mkv, D, 2048, gi * 32, kb, (bf16_t*)(ws + WS_WKV), gi * 32, nullptr, scr, F.lane); continue; } r -= I_KV;
        if (r < I_GU) { const int gi = r >> 4, kb = r & 15; const int tile = gi >> 3, up = (gi >> 2) & 1, q = gi & 3;
            p0_transpose_item(up ? w_up : w_gate, D, DFF, tile * 128 + q * 32, kb, (bf16_t*)(ws + WS_WGU), gi * 32, a.in[17], scr, F.lane); continue; } r -= I_GU;
        { const int gi = r / 44, kb = r % 44; p0_transpose_item(w_down, DFF, D, gi * 32, kb, (bf16_t*)(ws + WS_WD), gi * 32, nullptr, scr, F.lane); }
    }
    for (int i = gw; i < D; i += NGW) { const float gq = a.in[12][i]; const GAS f32x4* src = (const GAS f32x4*)(w_mq + (size_t)i * D) + F.lane; GAS unsigned long long* dst = (GAS unsigned long long*)((bf16_t*)(ws + WS_WQNB) + (size_t)i * D) + F.lane;
#pragma unroll
        for (int j = 0; j < 4; ++j) { const f32x4 v = src[64 * j]; dst[64 * j] = (unsigned long long)pk2(v.x * gq, v.y * gq) | ((unsigned long long)pk2(v.z * gq, v.w * gq) << 32); } }
    for (int e = gw * 64 + F.lane; e < SEQ * 32; e += NGW * 64) { const int t = e >> 5, i = e & 31; const float inv = powf(10000.0f, -(float)(2 * i) / 64.0f); const float ang = (float)t * inv;
        ((f32x2*)(ws + WS_ROPE))[e] = (f32x2){(float)cos((double)ang), (float)sin((double)ang)}; }
    for (int m = gw; m < MM; m += NGW) rms_row_to_bf16(a.in[1] + (size_t)m * D, a.in[13], (bf16_t*)(ws + WS_MEMN) + (size_t)m * D, F.lane);
    for (int m = gw; m < M; m += NGW) rms_row_to_bf16(a.in[0] + (size_t)m * D, a.in[2], (bf16_t*)(ws + WS_XB) + (size_t)m * D, F.lane);
}

__device__ __forceinline__ void conv_unit(const Frame& F, const Args& a, int unit) {
    unsigned char* ws = a.ws;
    const bf16_t* VGLU = (const bf16_t*)(ws + WS_VGLU); bf16_t* YMIX = (bf16_t*)(ws + WS_YMIX);
    LAS unsigned char* in_l = F.lds;
    LAS float* out_l = (LAS float*)(F.lds + 63488);
    const int b = unit >> 7, t0 = (unit & 127) * 32;
    for (int ch = F.tid; ch < 62 * 64; ch += 512) { const int r = ch >> 6, c16 = ch & 63; const int t = t0 - CPAD + r;
        u32x4 v = (u32x4){0u, 0u, 0u, 0u};
        if (t >= 0 && t < SEQ) v = *(const u32x4*)(VGLU + ((size_t)(b * SEQ + t)) * CCH + c16 * 8);
        *(LAS u32x4*)(in_l + r * 1024 + c16 * 16) = v; }
    __syncthreads();
    {
        const int cp = F.tid & 255, th = F.tid >> 8;
        const float* w_dw = a.in[5]; const float* b_dw = a.in[6];
        f32x2 w[CW];
#pragma unroll
        for (int k = 0; k < CW; ++k) w[k] = *(const f32x2*)(w_dw + k * CCH + 2 * cp);
        const f32x2 bias = *(const f32x2*)(b_dw + 2 * cp);
        f32x2 acc[16];
#pragma unroll
        for (int t = 0; t < 16; ++t) acc[t] = bias;
#pragma unroll
        for (int i = 0; i < 46; ++i) { const unsigned xv = *(const LAS unsigned*)(in_l + (th * 16 + i) * 1024 + cp * 4); const f32x2 x = (f32x2){__uint_as_float(xv << 16), __uint_as_float(xv & 0xffff0000u)};
#pragma unroll
            for (int t = 0; t < 16; ++t) { const int k = i - t; if (k >= 0 && k < CW) acc[t] += w[k] * x; } }
#pragma unroll
        for (int t = 0; t < 16; ++t) *(LAS f32x2*)(out_l + (th * 16 + t) * CCH + 2 * cp) = acc[t];
    }
    __syncthreads();
    {
        const float* lg = a.in[7]; const float* lb = a.in[8];
        const f32x4 g0 = *(const f32x4*)(lg + F.lane * 8), g1 = *(const f32x4*)(lg + F.lane * 8 + 4), b0 = *(const f32x4*)(lb + F.lane * 8), b1 = *(const f32x4*)(lb + F.lane * 8 + 4);
#pragma unroll
        for (int q = 0; q < 4; ++q) { const int tok = F.wave * 4 + q;
            const f32x4 y0 = *(const LAS f32x4*)(out_l + tok * CCH + F.lane * 8), y1 = *(const LAS f32x4*)(out_l + tok * CCH + F.lane * 8 + 4);
            const float mu = wave_sum((y0[0] + y0[1]) + (y0[2] + y0[3]) + (y1[0] + y1[1]) + (y1[2] + y1[3])) * (1.0f / CCH);
            const f32x4 d0 = y0 - mu, d1 = y1 - mu;
            const float var = wave_sum((d0[0] * d0[0] + d0[1] * d0[1]) + (d0[2] * d0[2] + d0[3] * d0[3]) + (d1[0] * d1[0] + d1[1] * d1[1]) + (d1[2] * d1[2] + d1[3] * d1[3])) * (1.0f / CCH);
            const float rstd = rsqrtf(var + EPS);
            f32x4 z0 = d0 * rstd * g0 + b0, z1 = d1 * rstd * g1 + b1;
#pragma unroll
            for (int j = 0; j < 4; ++j) { z0[j] = z0[j] * sigmoid_fast(z0[j]); z1[j] = z1[j] * sigmoid_fast(z1[j]); }
            u32x4 o; o.x = cvt_pk_bf16(z0[0], z0[1]); o.y = cvt_pk_bf16(z0[2], z0[3]); o.z = cvt_pk_bf16(z1[0], z1[1]); o.w = cvt_pk_bf16(z1[2], z1[3]);
            *(u32x4*)(YMIX + (size_t)(b * SEQ + t0 + tok) * D + F.lane * 8) = o; }
    }
    __syncthreads();
}

__device__ __forceinline__ int crow(int r, int hi) { return (r & 3) + 8 * (r >> 2) + 4 * hi; }
__device__ __forceinline__ void attn_wave(const Args& a, int b, int h, int rb, int lane) {
    unsigned char* ws = a.ws;
    const bf16_t* Q = (const bf16_t*)(ws + WS_Q); const bf16_t* Kb = (const bf16_t*)(ws + WS_K); const bf16_t* VT = (const bf16_t*)(ws + WS_VT); bf16_t* YMIX = (bf16_t*)(ws + WS_YMIX);
    const int r32 = lane & 31, hi = lane >> 5, kvh = h >> 2, r0 = rb * 32;
    const bf16_t* qp = Q + (size_t)(b * SEQ + r0 + r32) * 512 + h * 64 + 8 * hi;
    bf16x8 qf[4];
#pragma unroll
    for (int d0 = 0; d0 < 4; ++d0) qf[d0] = *(const bf16x8*)(qp + 16 * d0);
    const bf16_t* kbase = Kb + (size_t)(b * 2 + kvh) * SEQ * 64 + 8 * hi;
    const bf16_t* vbase = VT + ((size_t)(b * 2 + kvh) * 64 + r32) * SEQ + 4 * hi;
    float mrun = a.in[9][h] * LOG2E, lrun = (hi == 0) ? 1.0f : 0.0f;
    f32x16 o0 = {}, o1 = {};
    for (int i = 0; i < 9; ++i) {
        const int kt = r0 - 128 + 32 * i;
        if (kt < 0 || kt >= SEQ) continue;
        bf16x8 kf[4];
#pragma unroll
        for (int d0 = 0; d0 < 4; ++d0) kf[d0] = *(const bf16x8*)(kbase + (size_t)(kt + r32) * 64 + 16 * d0);
        s16x4 va[2][2][2];
#pragma unroll
        for (int db = 0; db < 2; ++db)
#pragma unroll
            for (int s = 0; s < 2; ++s)
#pragma unroll
                for (int hf = 0; hf < 2; ++hf) va[db][s][hf] = *(const s16x4*)(vbase + (size_t)(32 * db) * SEQ + kt + 16 * s + 8 * hf);
        f32x16 S = {};
#pragma unroll
        for (int d0 = 0; d0 < 4; ++d0) S = __builtin_amdgcn_mfma_f32_32x32x16_bf16(kf[d0], qf[d0], S, 0, 0, 0);
        if (i == 0) {
#pragma unroll
            for (int r = 0; r < 16; ++r) if (crow(r, hi) < r32) S[r] = -INFINITY;
        }
        if (i == 8) {
#pragma unroll
            for (int r = 0; r < 16; ++r) if (crow(r, hi) > r32) S[r] = -INFINITY;
        }
        float tmax = S[0];
#pragma unroll
        for (int r = 1; r < 16; ++r) tmax = fmaxf(tmax, S[r]);
        tmax = fmaxf(tmax, __shfl_xor(tmax, 32));
        const float mnew = fmaxf(mrun, tmax); const float alpha = __builtin_amdgcn_exp2f(mrun - mnew); mrun = mnew;
        float psum = 0.f;
#pragma unroll
        for (int r = 0; r < 16; ++r) { S[r] = __builtin_amdgcn_exp2f(S[r] - mnew); psum += S[r]; }
        lrun = lrun * alpha + psum;
#pragma unroll
        for (int r = 0; r < 16; ++r) { o0[r] *= alpha; o1[r] *= alpha; }
        u32x4 p0, p1;
        p0.x = cvt_pk_bf16(S[0], S[1]); p0.y = cvt_pk_bf16(S[2], S[3]); p0.z = cvt_pk_bf16(S[4], S[5]); p0.w = cvt_pk_bf16(S[6], S[7]);
        p1.x = cvt_pk_bf16(S[8], S[9]); p1.y = cvt_pk_bf16(S[10], S[11]); p1.z = cvt_pk_bf16(S[12], S[13]); p1.w = cvt_pk_bf16(S[14], S[15]);
        const bf16x8 pb0 = __builtin_bit_cast(bf16x8, p0), pb1 = __builtin_bit_cast(bf16x8, p1);
#define VFRAG(db, s) (bf16x8){va[db][s][0][0], va[db][s][0][1], va[db][s][0][2], va[db][s][0][3], va[db][s][1][0], va[db][s][1][1], va[db][s][1][2], va[db][s][1][3]}
        o0 = __builtin_amdgcn_mfma_f32_32x32x16_bf16(VFRAG(0, 0), pb0, o0, 0, 0, 0);
        o0 = __builtin_amdgcn_mfma_f32_32x32x16_bf16(VFRAG(0, 1), pb1, o0, 0, 0, 0);
        o1 = __builtin_amdgcn_mfma_f32_32x32x16_bf16(VFRAG(1, 0), pb0, o1, 0, 0, 0);
        o1 = __builtin_amdgcn_mfma_f32_32x32x16_bf16(VFRAG(1, 1), pb1, o1, 0, 0, 0);
#undef VFRAG
    }
    const float inv = __builtin_amdgcn_rcpf(lrun + __shfl_xor(lrun, 32));
    bf16_t* op = YMIX + (size_t)(b * SEQ + r0 + r32) * D + 512 + h * 64 + 4 * hi;
#pragma unroll
    for (int g4 = 0; g4 < 4; ++g4) {
        u32x2 w0, w1;
        w0.x = cvt_pk_bf16(o0[4 * g4] * inv, o0[4 * g4 + 1] * inv); w0.y = cvt_pk_bf16(o0[4 * g4 + 2] * inv, o0[4 * g4 + 3] * inv);
        w1.x = cvt_pk_bf16(o1[4 * g4] * inv, o1[4 * g4 + 1] * inv); w1.y = cvt_pk_bf16(o1[4 * g4 + 2] * inv, o1[4 * g4 + 3] * inv);
        *(u32x2*)(op + 8 * g4) = w0; *(u32x2*)(op + 32 + 8 * g4) = w1;
    }
}

__global__ void __launch_bounds__(NWAVES * 64, 2) fwd_kernel(Args args) {
    extern __shared__ __attribute__((aligned(16))) unsigned char lds_raw[];
#define MKFRAME() Frame F; F.lds = (LAS unsigned char*)lds_raw; F.tid = tid_now(wave_s); F.lane = F.tid & 63; F.wave = wave_s; \
    F.G = gridDim.x; { const int bx_ = blockIdx.x; F.vcu = (F.G % 8 == 0) ? (bx_ % 8) * (F.G / 8) + bx_ / 8 : bx_; }
    unsigned char* ws = args.ws;
    const int wave_s = __builtin_amdgcn_readfirstlane((int)threadIdx.x >> 6);
    volatile LAS unsigned* MISC = (volatile LAS unsigned*)((LAS unsigned char*)lds_raw + MISC_OFF);
    if (threadIdx.x < 32) MISC[threadIdx.x] = 0u;
    __syncthreads();
    XcdBarrier bar; bar.bar = (unsigned*)(ws + WS_CTL) + CW_BAR; bar.x = 0; bar.st = nullptr;
    if (MK_N_LAUNCHES == 1) bar = xcd_barrier_post((unsigned*)(ws + WS_CTL) + CW_BAR, MISC + 8, (int)threadIdx.x);
    const int lo = args.ph_lo, hi = args.ph_hi;
#ifndef PH_MASK
#define PH_MASK 0x1ff
#endif
#define IN(k) (((PH_MASK >> (k)) & 1) && lo <= (k) && (k) < hi)
#define SEAM(k) do { if (IN(k) && IN((k) + 1)) xcd_barrier(bar, tid_now(wave_s)); } while (0)
    const int G = gridDim.x, bx = (int)blockIdx.x; LAS unsigned char* const lds = (LAS unsigned char*)lds_raw;
    bf16_t* XB = (bf16_t*)(ws + WS_XB); float* X1 = (float*)(ws + WS_X1);

    if (IN(0)) { MKFRAME(); p0_prologue(F, args); SEAM(0); }

    if (IN(1)) {
        { pg8::Gemm g{XB, (const bf16_t*)(ws + WS_WIN), D, D, D}; pg8::StaticOrder S; S.init(M, IN_COLS, G, bx, D, D);
          pg8::EpiIn E{args.in[4], (const float*)(ws + WS_ROPE), (bf16_t*)(ws + WS_VGLU), (bf16_t*)(ws + WS_Q), (bf16_t*)(ws + WS_K), (bf16_t*)(ws + WS_VT)};
          pg8::gemm_phase<pg8::EpiIn, pg8::StaticOrder, true>(lds, g, S, E, wave_s); }
        { pg8::Gemm g{(const bf16_t*)(ws + WS_MEMN), (const bf16_t*)(ws + WS_WKV), D, D, D}; pg8::StaticOrder S; S.init(MM, 2048, G, (bx + G - 128) % G, D, D);
          pg8::EpiKV E{(bf16_t*)(ws + WS_KM), (bf16_t*)(ws + WS_VM)};
          pg8::gemm_phase<pg8::EpiKV, pg8::StaticOrder, true>(lds, g, S, E, wave_s); }
        SEAM(1);
    }

    if (IN(2)) {
#ifndef P2_PART
#define P2_PART 7
#endif
        if (P2_PART & 1) {
        { pg8::Gemm g{(const bf16_t*)ws, (const bf16_t*)ws, D, D, 256}; pg8::SmallOrder S{bx, G}; pg8::EpiBf16 E{(bf16_t*)ws, D};
          pg8::gemm_phase<pg8::EpiBf16, pg8::SmallOrder, true>(lds, g, S, E, wave_s); }
        }
        __syncthreads();
        MKFRAME();
        if (P2_PART & 2) for (int u = F.vcu; u < 1024; u += G) conv_unit(F, args, u);
        if (P2_PART & 4) for (int wt = F.vcu; wt < 1024; wt += G) { const int b = wt >> 7, h = (wt >> 4) & 7, rb8 = wt & 15; attn_wave(args, b, h, rb8 * 8 + F.wave, F.lane); }
        SEAM(2);
    }

    if (IN(3)) {
        pg8::Gemm g{(const bf16_t*)(ws + WS_YMIX), (const bf16_t*)(ws + WS_WOUT), D, D, D}; pg8::StaticOrder S; S.init(M, D, G, bx, D, D);
        pg8::EpiRes E{args.in[0], X1, XB, args.in[11], (float*)(ws + WS_ST1)};
        pg8::gemm_phase<pg8::EpiRes, pg8::StaticOrder, true>(lds, g, S, E, wave_s);
        SEAM(3);
    }

    if (IN(4)) {
        pg8::Gemm g{XB, (const bf16_t*)(ws + WS_WQK), D, D, D}; pg8::StaticOrder S; S.init(M, D, G, bx, D, D, 16, (size_t)1048576);
        pg8::EpiSoftmax E{(const float*)(ws + WS_ST1), (bf16_t*)(ws + WS_P), (LAS f32x2*)(lds + XTAB_OFF)};
        pg8::gemm_phase<pg8::EpiSoftmax, pg8::StaticOrder, true>(lds, g, S, E, wave_s);
        SEAM(4);
    }

    if (IN(5)) {
        pg8::Gemm g{(const bf16_t*)(ws + WS_P), (const bf16_t*)(ws + WS_VWO), D, D, D}; pg8::StaticOrder S; S.init(M, D, G, bx, D, D, 16, (size_t)1048576);
        pg8::EpiRes E{X1, X1, XB, nullptr, (float*)(ws + WS_ST2)};
        pg8::gemm_phase<pg8::EpiRes, pg8::StaticOrder, true>(lds, g, S, E, wave_s);
        SEAM(5);
    }

    if (IN(6)) {
        pg8::Gemm g{XB, (const bf16_t*)(ws + WS_WGU), D, D, D}; pg8::StaticOrder S; S.init(M, 2 * DFF, G, bx, D, D);
        pg8::EpiSwiglu E{(const float*)(ws + WS_ST2), (bf16_t*)(ws + WS_G)};
        pg8::gemm_phase<pg8::EpiSwiglu, pg8::StaticOrder, true>(lds, g, S, E, wave_s);
        SEAM(6);
    }

    if (IN(7)) {
        pg8::Gemm g{(const bf16_t*)(ws + WS_G), (const bf16_t*)(ws + WS_WD), DFF, DFF, DFF}; pg8::StaticOrder S; S.init(M, D, G, bx, DFF, DFF);
        pg8::EpiRes E{X1, args.out, nullptr, nullptr, (float*)(ws + WS_ST3)};
        pg8::gemm_phase<pg8::EpiRes, pg8::StaticOrder, true>(lds, g, S, E, wave_s);
        SEAM(7);
    }

    if (IN(8)) {
        MKFRAME();
        const int gw = F.vcu * NWAVES + F.wave, NGW = G * NWAVES; const float* gf = args.in[21]; const float* ST3 = (const float*)(ws + WS_ST3);
        for (int m = gw; m < M; m += NGW) { const float rs = pg8::row_rs(ST3, m); GAS f32x4* o = (GAS f32x4*)(args.out + (size_t)m * D) + F.lane; const GAS f32x4* gg = (const GAS f32x4*)gf + F.lane;
#pragma unroll
            for (int j = 0; j < 4; ++j) { const f32x4 v = o[64 * j]; o[64 * j] = v * rs * gg[64 * j]; } }
    }
#undef IN
#undef SEAM
}

extern "C" void kernel_launch(void* const* d_in, const int* in_sizes, int n_in, void* d_out, int out_size, void* d_ws, size_t ws_size, hipStream_t stream) {
    static int grid = 0;
    if (grid == 0) {
        if (n_in != 22 || out_size != M * D || ws_size < WS_END) { fprintf(stderr, "kernel_launch: unexpected shapes (n_in %d out %d ws %zu)\n", n_in, out_size, ws_size); grid = -1; return; }
        int dev = 0, cus = 0, per_cu = 0;
        if (hipGetDevice(&dev) != hipSuccess || hipDeviceGetAttribute(&cus, hipDeviceAttributeMultiprocessorCount, dev) != hipSuccess) { grid = -1; return; }
        if (hipFuncSetAttribute((const void*)fwd_kernel, hipFuncAttributeMaxDynamicSharedMemorySize, LDS_BYTES) != hipSuccess) { fprintf(stderr, "kernel_launch: hipFuncSetAttribute failed\n"); grid = -1; return; }
        if (hipOccupancyMaxActiveBlocksPerMultiprocessor(&per_cu, (const void*)fwd_kernel, NWAVES * 64, LDS_BYTES) != hipSuccess || per_cu < 1) { fprintf(stderr, "kernel_launch: occupancy query says %d\n", per_cu); per_cu = 1; }
        (void)hipGetLastError();
        grid = cus * (per_cu < 1 ? 1 : 1);
    }
    if (grid < 0) return;
    (void)hipMemsetAsync((char*)d_ws + WS_CTL, 0, CTL_ZERO_BYTES, stream);
    Args a{};
    for (int i = 0; i < 22; ++i) a.in[i] = (const float*)d_in[i];
    a.out = (float*)d_out; a.ws = (unsigned char*)d_ws;
    constexpr int NPH = 9;
    if (MK_N_LAUNCHES == 1) { a.ph_lo = 0; a.ph_hi = NPH; a.li = 0; hipLaunchKernelGGL(fwd_kernel, dim3(grid), dim3(NWAVES * 64), LDS_BYTES, stream, a); }
    else for (int p = 0; p < NPH; ++p) { a.ph_lo = p; a.ph_hi = p + 1; a.li = p; hipLaunchKernelGGL(fwd_kernel, dim3(grid), dim3(NWAVES * 64), LDS_BYTES, stream, a); }
}
```

```cpp
#include <hip/hip_runtime.h>
#include <cstdint>
#include <cstdio>

#ifndef MK_N_LAUNCHES
#define MK_N_LAUNCHES 1
#endif

#define LAS __attribute__((address_space(3)))
#define GAS __attribute__((address_space(1)))
typedef unsigned short bf16_t;
typedef short bf16x8 __attribute__((ext_vector_type(8)));
typedef short s16x4 __attribute__((ext_vector_type(4)));
typedef float f32x4 __attribute__((ext_vector_type(4)));
typedef float f32x2 __attribute__((ext_vector_type(2)));
typedef float f32x16 __attribute__((ext_vector_type(16)));
typedef unsigned u32x4 __attribute__((ext_vector_type(4)));
typedef unsigned u32x2 __attribute__((ext_vector_type(2)));

constexpr int D = 1024, BATCH = 8, SEQ = 4096, M = BATCH * SEQ, MEMLEN = 256, MM = BATCH * MEMLEN;
constexpr int CCH = 512, CW = 31, CPAD = 15, HD = 64, NQH = 8, NKVH = 2;
constexpr int IN_COLS = 1792, DFF = 2816, MHD = 256;
constexpr float EPS = 1e-6f;
constexpr float LOG2E = 1.4426950408889634f;
constexpr float QSCALE = 0.125f * LOG2E;
constexpr float MSCALE = 0.0625f * LOG2E;

constexpr size_t MiB = 1u << 20;
constexpr size_t WS_CTL = 0, CTL_ZERO_BYTES = 1 * MiB;
constexpr size_t WS_ROPE = 1 * MiB;
constexpr size_t WS_ST1 = 2 * MiB, WS_ST2 = 4 * MiB, WS_ST3 = 6 * MiB;
constexpr size_t WS_WIN = 8 * MiB;
constexpr size_t WS_WOUT = 12 * MiB;
constexpr size_t WS_WQNB = 14 * MiB;
constexpr size_t WS_WOT = 16 * MiB;
constexpr size_t WS_WKV = 18 * MiB;
constexpr size_t WS_WGU = 22 * MiB;
constexpr size_t WS_WD = 33 * MiB;
constexpr size_t WS_MEMN = 39 * MiB;
constexpr size_t WS_KM = 43 * MiB, WS_VM = 47 * MiB;
constexpr size_t WS_WQK = 51 * MiB;
constexpr size_t WS_VWO = 67 * MiB;
constexpr size_t WS_XB = 84 * MiB;
constexpr size_t WS_X1 = 148 * MiB;
constexpr size_t WS_VGLU = 276 * MiB;
constexpr size_t WS_Q = 308 * MiB;
constexpr size_t WS_K = 340 * MiB;
constexpr size_t WS_VT = 348 * MiB;
constexpr size_t WS_YMIX = 356 * MiB;
constexpr size_t WS_P = 420 * MiB;
constexpr size_t WS_G = 276 * MiB;
constexpr size_t WS_END = 512 * MiB;
static_assert(WS_G + (size_t)M * DFF * 2 <= WS_END && WS_P + (size_t)M * D * 2 <= WS_END, "ws map");
constexpr int CW_TMO = 0, CW_CODE = 1, CW_BAR = 4096;

constexpr int RING_BYTES = 131072;
constexpr int XTAB_OFF = RING_BYTES;
constexpr int MISC_OFF = XTAB_OFF + 8192;
constexpr int LDS_BYTES = 147456;

__device__ __forceinline__ unsigned cvt_pk_bf16(float lo, float hi) { unsigned r; asm volatile("v_cvt_pk_bf16_f32 %0, %1, %2" : "=v"(r) : "v"(lo), "v"(hi)); return r; }
__device__ __forceinline__ float bf16_to_f32(unsigned short b) { return __uint_as_float((unsigned)b << 16); }
__device__ __forceinline__ float sigmoid_fast(float x) { return __builtin_amdgcn_rcpf(1.0f + __builtin_amdgcn_exp2f(-x * LOG2E)); }
__device__ __forceinline__ float wave_sum(float v) {
#pragma unroll
    for (int o = 1; o < 64; o <<= 1) v += __shfl_xor(v, o);
    return v;
}
__device__ __forceinline__ int tid_now(int wave_s) { int l = (int)__builtin_amdgcn_mbcnt_hi(~0u, __builtin_amdgcn_mbcnt_lo(~0u, 0u)); asm volatile("" : "+v"(l)); return wave_s * 64 + l; }
#define LDS_WAIT() asm volatile("s_waitcnt lgkmcnt(0)" ::: "memory")
#define VM_WAIT() asm volatile("s_waitcnt vmcnt(0)" ::: "memory")

namespace pg8 {
constexpr int BM = 256, BK = 64, HALF = 128, HTB = HALF * BK * 2, NXCD = 8, WGM = 8;
__host__ __device__ __forceinline__ int lds_byte(int r, int c) { const int st = (r >> 4) * 2 + (c >> 5), rr = r & 15, cc = c & 31, ob = rr * 64 + cc * 2; return st * 1024 + (ob ^ (((ob >> 9) & 1) << 5)); }
__host__ __device__ __forceinline__ void stage_rc(int b, int& R, int& C) { const int st = b / 1024, sb = b % 1024, swz = sb ^ (((sb >> 9) & 1) << 5); R = (st >> 1) * 16 + swz / 64; C = (st & 1) * 32 + (swz % 64) / 2; }
__host__ __device__ __forceinline__ int perm32(int rho) { const int n = rho >> 4, i = rho & 15; return 8 * (i >> 2) + 4 * n + (i & 3); }

struct Unit { int pm, pn; unsigned aoff, boff, ooff; };
struct Gemm { const bf16_t* A; const bf16_t* Bt; int lda, ldb, K; };

struct StaticOrder {
    int nM, nN, nwg, G, c, lda, ldb, pm_per_b; size_t bstride;
    __device__ void init(int Mr, int N, int G_, int c_, int lda_, int ldb_, int pmpb = 0, size_t bstr = 0) { nM = Mr / BM; nN = N / BM; nwg = nM * nN; G = G_; c = c_; lda = lda_; ldb = ldb_; pm_per_b = pmpb; bstride = bstr; }
    __device__ bool next(int i, Unit& u) const {
        const long L = (long)i * G + c; if (L >= nwg) return false;
        int wgid = (int)L; { const int q = nwg / NXCD, r = nwg % NXCD, xcd = wgid % NXCD, off = wgid / NXCD; wgid = (xcd < r ? xcd * (q + 1) : r * (q + 1) + (xcd - r) * q) + off; }
        const int nig = WGM * nN, gid = wgid / nig, fm = gid * WGM, gsz = (nM - fm) < WGM ? (nM - fm) : WGM;
        u.pm = fm + ((wgid % nig) % gsz); u.pn = (wgid % nig) / gsz;
        u.aoff = (unsigned)(u.pm * BM * lda); u.boff = (unsigned)(u.pn * BM * ldb) + (pm_per_b ? (unsigned)(u.pm / pm_per_b) * (unsigned)bstride : 0u); u.ooff = 0u;
        return true;
    }
};
struct SmallOrder {
    int c, G;
    __device__ bool next(int i, Unit& u) const {
        const int L = i * G + c; if (L >= 256) return false;
        const int kind = L >> 7, z = (L & 127) >> 2, sub = L & 3, b = z >> 2, h = z & 3;
        if (kind == 0) { u.pm = 0; u.pn = sub; u.aoff = (unsigned)(WS_KM / 2) + (unsigned)(b * 256) * 1024u + h * 256; u.boff = (unsigned)(WS_WQNB / 2) + (unsigned)(sub * 256) * 1024u + h * 256; u.ooff = (unsigned)(WS_WQK / 2) + (unsigned)b * 1048576u + (unsigned)(h * 256) * 1024u; }
        else { u.pm = sub; u.pn = 0; u.aoff = (unsigned)(WS_WOT / 2) + (unsigned)(sub * 256) * 1024u + h * 256; u.boff = (unsigned)(WS_VM / 2) + (unsigned)(b * 256) * 1024u + h * 256; u.ooff = (unsigned)(WS_VWO / 2) + (unsigned)b * 1048576u + h * 256; }
        return true;
    }
};

template <class Epi, class Sched, bool ALIGN_EPI>
__device__ __forceinline__ void gemm_phase(LAS unsigned char* lds, const Gemm g, const Sched& S, const Epi& E, int wave_s) {
    const int tid = tid_now(wave_s), wid = wave_s, lane = tid & 63, wr = wid >> 2, wc = wid & 3, fr = lane & 15, fq = lane >> 4;
    const int K = g.K, nt = K / BK;
    unsigned voffA[2], voffB[2];
#pragma unroll
    for (int i = 0; i < 2; ++i) { int R, C; stage_rc(tid * 16 + i * 8192, R, C); const int Rb = Epi::PERM ? ((R & ~31) + perm32(R & 31)) : R;
        voffA[i] = (unsigned)(R * g.lda + C) * 2u; voffB[i] = (unsigned)(Rb * g.ldb + C) * 2u; }
    const size_t kstep = (size_t)(BK * 2);
    const size_t hstepA = (size_t)HALF * g.lda * 2, hstepB = (size_t)HALF * g.ldb * 2;
    const unsigned ldsw = (unsigned)wid * 1024u;
    const int aoff = lds_byte(wr * 64 + fr, fq * 8), boff = lds_byte(wc * 32 + fr, fq * 8);
#define PG8_SA(b, h) (((b) * 2 + (h)) * HTB)
#define PG8_SB(b, h) ((4 + (b) * 2 + (h)) * HTB)
#define PG8_STAGE(bufoff, gbase, voff) do { _Pragma("unroll") for (int _i = 0; _i < 2; ++_i) \
        __builtin_amdgcn_global_load_lds((const unsigned*)((const char*)(gbase) + (voff)[_i]), (LAS unsigned*)(lds + (bufoff) + ldsw + _i * 8192), 16, 0, 0); } while (0)
#define PG8_LDA(dst, b, h) do { _Pragma("unroll") for (int m = 0; m < 4; ++m) _Pragma("unroll") for (int k = 0; k < 2; ++k) dst[m][k] = *(const LAS bf16x8*)(lds + PG8_SA(b, h) + aoff + m * 2048 + k * 1024); } while (0)
#define PG8_LDB(dst, b, h) do { _Pragma("unroll") for (int n = 0; n < 2; ++n) _Pragma("unroll") for (int k = 0; k < 2; ++k) dst[n][k] = *(const LAS bf16x8*)(lds + PG8_SB(b, h) + boff + n * 2048 + k * 1024); } while (0)
#define PG8_MMA(ai, bj, At, Bt) do { __builtin_amdgcn_s_setprio(1); _Pragma("unroll") for (int m = 0; m < 4; ++m) _Pragma("unroll") for (int n = 0; n < 2; ++n) _Pragma("unroll") for (int k = 0; k < 2; ++k) \
        acc[ai][bj][m][n] = __builtin_amdgcn_mfma_f32_16x16x32_bf16(Bt[n][k], At[m][k], acc[ai][bj][m][n], 0, 0, 0); __builtin_amdgcn_s_setprio(0); } while (0)
#define PG8_WAIT_V(n) asm volatile("s_waitcnt vmcnt(" #n ")" ::: "memory")
#define PG8_WAIT_L(n) asm volatile("s_waitcnt lgkmcnt(" #n ")" ::: "memory")
#define PG8_BAR __builtin_amdgcn_s_barrier()
#define PG8_SCHED __builtin_amdgcn_sched_barrier(0)
    Unit cur, nxt; int ui = 0;
    if (!S.next(0, cur)) return;
    f32x4 acc[2][2][4][2];
#pragma unroll
    for (int a = 0; a < 2; ++a)
#pragma unroll
        for (int b = 0; b < 2; ++b)
#pragma unroll
            for (int m = 0; m < 4; ++m)
#pragma unroll
                for (int n = 0; n < 2; ++n) acc[a][b][m][n] = (f32x4){0.f, 0.f, 0.f, 0.f};
    bf16x8 At[4][2], B0[2][2], B1[2][2];
    const char* cA = (const char*)(g.A + cur.aoff); const char* cB = (const char*)(g.Bt + cur.boff);
    PG8_STAGE(PG8_SB(0, 0), cB, voffB); PG8_STAGE(PG8_SB(0, 1), cB + hstepB, voffB); PG8_STAGE(PG8_SA(0, 0), cA, voffA); PG8_STAGE(PG8_SA(0, 1), cA + hstepA, voffA);
    if (wr == 1) PG8_BAR;
    PG8_WAIT_V(2); PG8_BAR;
    PG8_STAGE(PG8_SB(1, 0), cB + kstep, voffB); PG8_STAGE(PG8_SA(1, 0), cA + kstep, voffA); PG8_STAGE(PG8_SB(1, 1), cB + hstepB + kstep, voffB);
    PG8_WAIT_V(6); PG8_BAR;
    for (;;) {
        const bool has_next = S.next(ui + 1, nxt);
        const char* nA = has_next ? (const char*)(g.A + nxt.aoff) : cA; const char* nB = has_next ? (const char*)(g.Bt + nxt.boff) : cB;
        for (int t = 0; t < nt; t += 2) {
            const bool last = (t == nt - 2);
            const char* a1 = cA + (size_t)(t + 1) * kstep;
            const char* a2 = last ? nA : cA + (size_t)(t + 2) * kstep; const char* b2 = last ? nB : cB + (size_t)(t + 2) * kstep;
            const char* a3 = a2 + kstep; const char* b3 = b2 + kstep;
            PG8_LDB(B0, 0, 0); PG8_LDB(B1, 0, 1); PG8_SCHED; PG8_LDA(At, 0, 0); PG8_STAGE(PG8_SA(1, 1), a1 + hstepA, voffA);
            PG8_WAIT_V(8); PG8_WAIT_L(0); PG8_BAR; PG8_MMA(0, 0, At, B0); PG8_MMA(0, 1, At, B1); PG8_BAR; PG8_SCHED;
            PG8_LDA(At, 0, 1); PG8_STAGE(PG8_SB(0, 0), b2, voffB); PG8_STAGE(PG8_SB(0, 1), b2 + hstepB, voffB); PG8_STAGE(PG8_SA(0, 0), a2, voffA);
            PG8_WAIT_V(8); PG8_WAIT_L(0); PG8_BAR; PG8_MMA(1, 0, At, B0); PG8_MMA(1, 1, At, B1); PG8_BAR; PG8_SCHED;
            PG8_LDB(B0, 1, 0); PG8_LDB(B1, 1, 1); PG8_SCHED; PG8_LDA(At, 1, 0); PG8_STAGE(PG8_SA(0, 1), a2 + hstepA, voffA);
            PG8_WAIT_V(8); PG8_WAIT_L(0); PG8_BAR; PG8_MMA(0, 0, At, B0); PG8_MMA(0, 1, At, B1); PG8_BAR; PG8_SCHED;
            PG8_LDA(At, 1, 1); PG8_STAGE(PG8_SB(1, 0), b3, voffB); PG8_STAGE(PG8_SB(1, 1), b3 + hstepB, voffB); PG8_STAGE(PG8_SA(1, 0), a3, voffA);
            PG8_WAIT_V(8); PG8_WAIT_L(0); PG8_BAR; PG8_MMA(1, 0, At, B0); PG8_MMA(1, 1, At, B1); PG8_BAR; PG8_SCHED;
        }
        if constexpr (ALIGN_EPI) { if (wr == 0) PG8_BAR; }
        { int l2 = lane; asm volatile("" : "+v"(l2)); E(acc, cur, wr, wc, l2 & 15, l2 >> 4); }
        if (!has_next) break;
#pragma unroll
        for (int a = 0; a < 2; ++a)
#pragma unroll
            for (int b = 0; b < 2; ++b)
#pragma unroll
                for (int m = 0; m < 4; ++m)
#pragma unroll
                    for (int n = 0; n < 2; ++n) acc[a][b][m][n] = (f32x4){0.f, 0.f, 0.f, 0.f};
        cur = nxt; cA = nA; cB = nB; ++ui;
        if constexpr (ALIGN_EPI) { if (wr == 1) PG8_BAR; }
    }
    PG8_WAIT_V(0);
    if constexpr (!ALIGN_EPI) { if (wr == 0) PG8_BAR; }
    PG8_BAR;
#undef PG8_SA
#undef PG8_SB
#undef PG8_STAGE
#undef PG8_LDA
#undef PG8_LDB
#undef PG8_MMA
#undef PG8_WAIT_V
#undef PG8_WAIT_L
#undef PG8_BAR
#undef PG8_SCHED
}

typedef f32x4 (&AccRef)[2][2][4][2];

struct EpiBf16 {
    static constexpr bool PERM = true;
    bf16_t* O; int ldc;
    __device__ __forceinline__ void operator()(AccRef acc, const Unit& u, int wr, int wc, int fr, int fq) const {
        bf16_t* base = O + u.ooff + (size_t)(u.pm * BM + wr * 64 + fr) * ldc + u.pn * BM + wc * 32 + 8 * fq;
#pragma unroll
        for (int ai = 0; ai < 2; ++ai)
#pragma unroll
            for (int m = 0; m < 4; ++m) { bf16_t* rowp = base + (size_t)(ai * HALF + m * 16) * ldc;
#pragma unroll
                for (int bj = 0; bj < 2; ++bj) { const f32x4 v0 = acc[ai][bj][m][0], v1 = acc[ai][bj][m][1];
                    u32x4 w; w.x = cvt_pk_bf16(v0[0], v0[1]); w.y = cvt_pk_bf16(v0[2], v0[3]); w.z = cvt_pk_bf16(v1[0], v1[1]); w.w = cvt_pk_bf16(v1[2], v1[3]);
                    *(u32x4*)(rowp + bj * HALF) = w; } }
    }
};
struct EpiKV {
    static constexpr bool PERM = true;
    bf16_t* KMp; bf16_t* VMp;
    __device__ __forceinline__ void operator()(AccRef acc, const Unit& u, int wr, int wc, int fr, int fq) const {
        bf16_t* O = (u.pn < 4) ? KMp : VMp; const int colt = (u.pn & 3) * BM;
        bf16_t* base = O + (size_t)(u.pm * BM + wr * 64 + fr) * 1024 + colt + wc * 32 + 8 * fq;
#pragma unroll
        for (int ai = 0; ai < 2; ++ai)
#pragma unroll
            for (int m = 0; m < 4; ++m) { bf16_t* rowp = base + (size_t)(ai * HALF + m * 16) * 1024;
#pragma unroll
                for (int bj = 0; bj < 2; ++bj) { const f32x4 v0 = acc[ai][bj][m][0], v1 = acc[ai][bj][m][1];
                    u32x4 w; w.x = cvt_pk_bf16(v0[0], v0[1]); w.y = cvt_pk_bf16(v0[2], v0[3]); w.z = cvt_pk_bf16(v1[0], v1[1]); w.w = cvt_pk_bf16(v1[2], v1[3]);
                    *(u32x4*)(rowp + bj * HALF) = w; } }
    }
};
struct EpiIn {
    static constexpr bool PERM = true;
    const float* b_in; const float* rope; bf16_t* VGLU; bf16_t* Q; bf16_t* Kb; bf16_t* VT;
    __device__ __forceinline__ void operator()(AccRef acc, const Unit& u, int wr, int wc, int fr, int fq) const {
        const int row0 = u.pm * BM + wr * 64 + fr;
        if (u.pn < 4) {
            const int ch = u.pn * 128 + wc * 32 + 8 * fq;
            f32x4 ba[2], bg[2];
#pragma unroll
            for (int n = 0; n < 2; ++n) { ba[n] = *(const f32x4*)(b_in + ch + 4 * n); bg[n] = *(const f32x4*)(b_in + 512 + ch + 4 * n); }
#pragma unroll
            for (int ai = 0; ai < 2; ++ai)
#pragma unroll
                for (int m = 0; m < 4; ++m) { const int row = row0 + ai * HALF + m * 16; float v[8];
#pragma unroll
                    for (int n = 0; n < 2; ++n) { const f32x4 a = acc[ai][0][m][n] + ba[n], gt = acc[ai][1][m][n] + bg[n];
#pragma unroll
                        for (int j = 0; j < 4; ++j) v[4 * n + j] = a[j] * sigmoid_fast(gt[j]); }
                    u32x4 w; w.x = cvt_pk_bf16(v[0], v[1]); w.y = cvt_pk_bf16(v[2], v[3]); w.z = cvt_pk_bf16(v[4], v[5]); w.w = cvt_pk_bf16(v[6], v[7]);
                    *(u32x4*)(VGLU + (size_t)row * CCH + ch) = w; }
        } else if (u.pn < 6 || wc < 2) {
            const bool isq = u.pn < 6; const int head = isq ? (u.pn - 4) * 4 + wc : wc; const int d = 8 * fq;
            const int bcol = (isq ? 1024 : 1536) + head * 64 + d; const float sc = isq ? QSCALE : 1.0f;
            f32x4 b1[2], b2[2];
#pragma unroll
            for (int n = 0; n < 2; ++n) { b1[n] = *(const f32x4*)(b_in + bcol + 4 * n); b2[n] = *(const f32x4*)(b_in + bcol + 32 + 4 * n); }
#pragma unroll
            for (int ai = 0; ai < 2; ++ai)
#pragma unroll
                for (int m = 0; m < 4; ++m) { const int row = row0 + ai * HALF + m * 16; const int pos = row & (SEQ - 1);
                    const f32x4* cs = (const f32x4*)(rope + ((size_t)pos * 32 + d) * 2); float o1[8], o2[8];
#pragma unroll
                    for (int n = 0; n < 2; ++n) { const f32x4 t1 = acc[ai][0][m][n] + b1[n], t2 = acc[ai][1][m][n] + b2[n]; const f32x4 cA = cs[2 * n], cB = cs[2 * n + 1];
                        const float c[4] = {cA[0], cA[2], cB[0], cB[2]}, s[4] = {cA[1], cA[3], cB[1], cB[3]};
#pragma unroll
                        for (int j = 0; j < 4; ++j) { o1[4 * n + j] = (t1[j] * c[j] - t2[j] * s[j]) * sc; o2[4 * n + j] = (t1[j] * s[j] + t2[j] * c[j]) * sc; } }
                    u32x4 w1, w2; w1.x = cvt_pk_bf16(o1[0], o1[1]); w1.y = cvt_pk_bf16(o1[2], o1[3]); w1.z = cvt_pk_bf16(o1[4], o1[5]); w1.w = cvt_pk_bf16(o1[6], o1[7]);
                    w2.x = cvt_pk_bf16(o2[0], o2[1]); w2.y = cvt_pk_bf16(o2[2], o2[3]); w2.z = cvt_pk_bf16(o2[4], o2[5]); w2.w = cvt_pk_bf16(o2[6], o2[7]);
                    bf16_t* dst = isq ? (Q + (size_t)row * 512 + head * 64 + d) : (Kb + ((size_t)((row >> 12) * 2 + head) * SEQ + pos) * 64 + d);
                    *(u32x4*)dst = w1; *(u32x4*)(dst + 32) = w2; }
        } else {
            const int d0 = (wc - 2) * 32 + 8 * fq;
#pragma unroll
            for (int bj = 0; bj < 2; ++bj) { f32x4 bv[2];
#pragma unroll
                for (int n = 0; n < 2; ++n) bv[n] = *(const f32x4*)(b_in + 1664 + bj * 64 + d0 + 4 * n);
#pragma unroll
                for (int ai = 0; ai < 2; ++ai)
#pragma unroll
                    for (int m = 0; m < 4; ++m) { const int row = row0 + ai * HALF + m * 16; const int pos = row & (SEQ - 1);
                        bf16_t* dst = VT + ((size_t)((row >> 12) * 2 + bj) * 64 + d0) * SEQ + pos;
#pragma unroll
                        for (int n = 0; n < 2; ++n) { const f32x4 v = acc[ai][bj][m][n] + bv[n];
#pragma unroll
                            for (int j = 0; j < 4; j += 2) { const unsigned w = cvt_pk_bf16(v[j], v[j + 1]); dst[(size_t)(4 * n + j) * SEQ] = (bf16_t)(w & 0xffffu); dst[(size_t)(4 * n + j + 1) * SEQ] = (bf16_t)(w >> 16); } } }
            }
        }
    }
};
__device__ __forceinline__ void unpack8(const u32x4 w, float (&v)[8]) {
    v[0] = __uint_as_float(w.x << 16); v[1] = __uint_as_float(w.x & 0xffff0000u); v[2] = __uint_as_float(w.y << 16); v[3] = __uint_as_float(w.y & 0xffff0000u);
    v[4] = __uint_as_float(w.z << 16); v[5] = __uint_as_float(w.z & 0xffff0000u); v[6] = __uint_as_float(w.w << 16); v[7] = __uint_as_float(w.w & 0xffff0000u);
}
template <int MODE> struct EpiRes {
    static constexpr bool PERM = true;
    const float* xin; const float* bias; bf16_t* XB; float* OUT; float* ST;
    __device__ __forceinline__ void operator()(AccRef acc, const Unit& u, int wr, int wc, int fr, int fq) const {
        const int row0 = u.pm * BM + wr * 64 + fr, col0 = u.pn * BM + wc * 32 + 8 * fq;
        f32x4 bv[2][2];
        if (MODE == 0) {
#pragma unroll
            for (int bj = 0; bj < 2; ++bj)
#pragma unroll
                for (int n = 0; n < 2; ++n) bv[bj][n] = *(const f32x4*)(bias + col0 + bj * HALF + 4 * n);
        }
#pragma unroll
        for (int ai = 0; ai < 2; ++ai)
#pragma unroll
            for (int m = 0; m < 4; ++m) { const int row = row0 + ai * HALF + m * 16; const size_t off = (size_t)row * D + col0; float ss = 0.f;
#pragma unroll
                for (int bj = 0; bj < 2; ++bj) { float o[8];
                    if (MODE == 0) { const f32x4 x0 = *(const f32x4*)(xin + off + bj * HALF), x1 = *(const f32x4*)(xin + off + bj * HALF + 4);
                        const f32x4 a0 = x0 + acc[ai][bj][m][0] + bv[bj][0], a1 = x1 + acc[ai][bj][m][1] + bv[bj][1];
#pragma unroll
                        for (int j = 0; j < 4; ++j) { o[j] = a0[j]; o[4 + j] = a1[j]; } }
                    else { const u32x4 w = *(const u32x4*)(XB + off + bj * HALF); unpack8(w, o);
#pragma unroll
                        for (int j = 0; j < 4; ++j) { o[j] += acc[ai][bj][m][0][j]; o[4 + j] += acc[ai][bj][m][1][j]; } }
#pragma unroll
                    for (int j = 0; j < 8; ++j) ss += o[j] * o[j];
                    if (MODE == 2) { *(f32x4*)(OUT + off + bj * HALF) = (f32x4){o[0], o[1], o[2], o[3]}; *(f32x4*)(OUT + off + bj * HALF + 4) = (f32x4){o[4], o[5], o[6], o[7]}; }
                    else { u32x4 w; w.x = cvt_pk_bf16(o[0], o[1]); w.y = cvt_pk_bf16(o[2], o[3]); w.z = cvt_pk_bf16(o[4], o[5]); w.w = cvt_pk_bf16(o[6], o[7]); *(u32x4*)(XB + off + bj * HALF) = w; } }
                ss += __shfl_xor(ss, 16); ss += __shfl_xor(ss, 32);
                if (fq == 0) ST[(size_t)row * 16 + u.pn * 4 + wc] = ss; }
    }
};
__device__ __forceinline__ float row_rs(const float* ST, int row) {
    const f32x4* p = (const f32x4*)(ST + (size_t)row * 16); const f32x4 a = p[0], b = p[1], c = p[2], d = p[3];
    const float s = ((a[0] + a[1]) + (a[2] + a[3])) + ((b[0] + b[1]) + (b[2] + b[3])) + ((c[0] + c[1]) + (c[2] + c[3])) + ((d[0] + d[1]) + (d[2] + d[3]));
    return rsqrtf(s * (1.0f / D) + EPS);
}
struct EpiSoftmax {
    static constexpr bool PERM = true;
    const float* ST; bf16_t* P; LAS f32x2* tab;
    __device__ __forceinline__ void operator()(f32x4 (&acc)[2][2][4][2], const Unit& u, int wr, int wc, int fr, int fq) const {
        const int row0 = u.pm * BM + wr * 64 + fr; float mloc[8];
#pragma unroll
        for (int ai = 0; ai < 2; ++ai)
#pragma unroll
            for (int m = 0; m < 4; ++m) { const int q = ai * 4 + m; const int row = row0 + ai * HALF + m * 16; const float sc = row_rs(ST, row) * MSCALE; float mx = -INFINITY;
#pragma unroll
                for (int bj = 0; bj < 2; ++bj)
#pragma unroll
                    for (int n = 0; n < 2; ++n) { acc[ai][bj][m][n] = acc[ai][bj][m][n] * sc; const f32x4 s = acc[ai][bj][m][n]; mx = fmaxf(mx, fmaxf(fmaxf(s[0], s[1]), fmaxf(s[2], s[3]))); }
                mx = fmaxf(mx, __shfl_xor(mx, 16)); mx = fmaxf(mx, __shfl_xor(mx, 32)); mloc[q] = mx; float sum = 0.f;
#pragma unroll
                for (int bj = 0; bj < 2; ++bj)
#pragma unroll
                    for (int n = 0; n < 2; ++n) { f32x4 s = acc[ai][bj][m][n];
#pragma unroll
                        for (int j = 0; j < 4; ++j) { s[j] = __builtin_amdgcn_exp2f(s[j] - mx); sum += s[j]; }
                        acc[ai][bj][m][n] = s; }
                sum += __shfl_xor(sum, 16); sum += __shfl_xor(sum, 32);
                if (fq == 0) tab[(ai * HALF + wr * 64 + m * 16 + fr) * 4 + wc] = (f32x2){mx, sum}; }
        LDS_WAIT(); __builtin_amdgcn_s_barrier(); asm volatile("" ::: "memory");
#pragma unroll
        for (int ai = 0; ai < 2; ++ai)
#pragma unroll
            for (int m = 0; m < 4; ++m) { const int q = ai * 4 + m; const int lr = ai * HALF + wr * 64 + m * 16 + fr; const int row = u.pm * BM + lr;
                const f32x2 t0 = tab[lr * 4 + 0], t1 = tab[lr * 4 + 1], t2 = tab[lr * 4 + 2], t3 = tab[lr * 4 + 3];
                const float mg = fmaxf(fmaxf(t0.x, t1.x), fmaxf(t2.x, t3.x));
                const float L = t0.y * __builtin_amdgcn_exp2f(t0.x - mg) + t1.y * __builtin_amdgcn_exp2f(t1.x - mg) + t2.y * __builtin_amdgcn_exp2f(t2.x - mg) + t3.y * __builtin_amdgcn_exp2f(t3.x - mg);
                const float f = __builtin_amdgcn_exp2f(mloc[q] - mg) * __builtin_amdgcn_rcpf(L);
                bf16_t* rowp = P + (size_t)row * D + u.pn * BM + wc * 32 + 8 * fq;
#pragma unroll
                for (int bj = 0; bj < 2; ++bj) { const f32x4 v0 = acc[ai][bj][m][0] * f, v1 = acc[ai][bj][m][1] * f;
                    u32x4 w; w.x = cvt_pk_bf16(v0[0], v0[1]); w.y = cvt_pk_bf16(v0[2], v0[3]); w.z = cvt_pk_bf16(v1[0], v1[1]); w.w = cvt_pk_bf16(v1[2], v1[3]);
                    *(u32x4*)(rowp + bj * HALF) = w; } }
    }
};
struct EpiSwiglu {
    static constexpr bool PERM = true;
    const float* ST; bf16_t* G;
    __device__ __forceinline__ void operator()(AccRef acc, const Unit& u, int wr, int wc, int fr, int fq) const {
        const int row0 = u.pm * BM + wr * 64 + fr; const int col = u.pn * 128 + wc * 32 + 8 * fq;
#pragma unroll
        for (int ai = 0; ai < 2; ++ai)
#pragma unroll
            for (int m = 0; m < 4; ++m) { const int row = row0 + ai * HALF + m * 16; const float rs = row_rs(ST, row); float v[8];
#pragma unroll
                for (int n = 0; n < 2; ++n)
#pragma unroll
                    for (int j = 0; j < 4; ++j) { const float gt = acc[ai][0][m][n][j] * rs, up = acc[ai][1][m][n][j] * rs; v[4 * n + j] = gt * sigmoid_fast(gt) * up; }
                u32x4 w; w.x = cvt_pk_bf16(v[0], v[1]); w.y = cvt_pk_bf16(v[2], v[3]); w.z = cvt_pk_bf16(v[4], v[5]); w.w = cvt_pk_bf16(v[6], v[7]);
                *(u32x4*)(G + (size_t)row * DFF + col) = w; }
    }
};
}

typedef GAS unsigned gu32;
#define RLX_AGENT __ATOMIC_RELAXED, __HIP_MEMORY_SCOPE_AGENT
#define XB_TMO      128
#define XB_XCNT(j)  (256  + 64 * (j))
#define XB_XSUB(j)  (1280 + 64 * (j))
#define XB_XGEN(j)  (2304 + 64 * (j))
#define XB_TOP      3328
#define XB_TOPGEN   3392
#define XCD_BAR_WORDS 3456
#define XB_SPIN_CAP (1u << 18)
__device__ __forceinline__ unsigned xb_ld(unsigned* p)              { return __hip_atomic_load(p, __ATOMIC_RELAXED, __HIP_MEMORY_SCOPE_AGENT); }
__device__ __forceinline__ unsigned xb_add(unsigned* p, unsigned v) { return __hip_atomic_fetch_add(p, v, __ATOMIC_RELAXED, __HIP_MEMORY_SCOPE_AGENT); }
__device__ __forceinline__ unsigned xb_xcc_id() { return (unsigned)__builtin_amdgcn_s_getreg((3 << 11) | 20) & 0xFu; }
#define XB_SPIN(cond, bar) do { unsigned _sp = 0; while (cond) { __builtin_amdgcn_s_sleep(1); \
    if ((++_sp & 255u) == 0u) { if (xb_ld(&(bar)[XB_TMO])) break; if (_sp > XB_SPIN_CAP) { atomicAdd(&(bar)[XB_TMO], 1u); break; } } } } while (0)
struct XcdBarrier { unsigned* bar; unsigned x; volatile LAS unsigned* st; };
__device__ __forceinline__ XcdBarrier xcd_barrier_post(unsigned* bar, volatile LAS unsigned* st, int tid) {
    XcdBarrier b; b.bar = bar; b.x = xb_xcc_id(); b.st = st;
    if (tid == 0) (void)xb_add(&bar[XB_XCNT(b.x)], 1u);
    return b;
}
__device__ __forceinline__ void xcd_barrier_complete(unsigned* bar, unsigned x, unsigned& nloc, unsigned& nx) {
    const unsigned G = gridDim.x * gridDim.y * gridDim.z;
    unsigned sum, cnt, mine, sp = 0u;
    for (;;) {
        sum = 0u; cnt = 0u; mine = 0u;
#pragma unroll
        for (unsigned j = 0; j < 16; ++j) { const unsigned c = xb_ld(&bar[XB_XCNT(j)]); sum += c; cnt += (c > 0u) ? 1u : 0u; mine = (j == x) ? c : mine; }
        if (sum == G) break;
        __builtin_amdgcn_s_sleep(1);
        if ((++sp & 255u) == 0u) { if (xb_ld(&bar[XB_TMO])) break; if (sp > XB_SPIN_CAP) { atomicAdd(&bar[XB_TMO], 1u); break; } }
    }
    nloc = mine > 0u ? mine : 1u; nx = cnt > 0u ? cnt : 1u;
}
__device__ __forceinline__ void xcd_barrier(const XcdBarrier& b, int tid) {
    asm volatile("s_waitcnt vmcnt(0)" ::: "memory");
    __syncthreads();
    if (tid == 0) {
        unsigned* bar = b.bar;
        __builtin_amdgcn_s_waitcnt(0);
        unsigned nloc = b.st[0], nx = b.st[1];
        if (nloc == 0u) { xcd_barrier_complete(bar, b.x, nloc, nx); b.st[0] = nloc; b.st[1] = nx; }
        const unsigned old = xb_add(&bar[XB_XSUB(b.x)], 1u);
        const unsigned gen = old / nloc;
        if (old + 1u == (gen + 1u) * nloc) {
            __builtin_amdgcn_fence(__ATOMIC_RELEASE, "agent");
            asm volatile("s_waitcnt vmcnt(0)" ::: "memory");
            const unsigned og = xb_add(&bar[XB_TOP], 1u);
            const unsigned tg = og / nx;
            if (og + 1u == (tg + 1u) * nx) xb_add(&bar[XB_TOPGEN], 1u);
            else XB_SPIN(xb_ld(&bar[XB_TOPGEN]) == tg, bar);
            __builtin_amdgcn_fence(__ATOMIC_ACQUIRE, "agent");
            xb_add(&bar[XB_XGEN(b.x)], 1u);
            asm volatile("s_waitcnt vmcnt(0)" ::: "memory");
        } else {
            XB_SPIN(xb_ld(&bar[XB_XGEN(b.x)]) == gen, bar);
            __builtin_amdgcn_fence(__ATOMIC_ACQUIRE, "agent");
            asm volatile("s_waitcnt vmcnt(0)" ::: "memory");
        }
    }
    __syncthreads();
}

constexpr int NWAVES = 8;
struct Args { const float* in[22]; float* out; unsigned char* ws; int ph_lo, ph_hi, li, pad; };
struct Frame { LAS unsigned char* lds; int tid, lane, wave, vcu, G; };

__device__ __forceinline__ unsigned f2bf(float f) { unsigned u = __builtin_bit_cast(unsigned, f); return (u + 0x7fffu + ((u >> 16) & 1u)) >> 16; }
__device__ __forceinline__ unsigned pk2(float lo, float hi) { return f2bf(lo) | (f2bf(hi) << 16); }
__device__ __forceinline__ void p0_transpose_item(const float* W, int K, int N, int src_col0, int kb, bf16_t* WT, int dst_row0, const float* g, LAS float* scr, int lane) {
    const int k0 = 64 * kb;
#pragma unroll
    for (int i = 0; i < 32; ++i) { const int kk = 2 * i + (lane >> 5); float v = W[(size_t)(k0 + kk) * N + src_col0 + (lane & 31)]; if (g) v *= g[k0 + kk]; scr[kk * 33 + (lane & 31)] = v; }
    LDS_WAIT(); asm volatile("" ::: "memory");
    const int c = lane & 7;
#pragma unroll
    for (int j = 0; j < 4; ++j) { const int n = (lane >> 3) + 8 * j; const LAS float* s = scr + (8 * c) * 33 + n;
        u32x4 o; o.x = pk2(s[0 * 33], s[1 * 33]); o.y = pk2(s[2 * 33], s[3 * 33]); o.z = pk2(s[4 * 33], s[5 * 33]); o.w = pk2(s[6 * 33], s[7 * 33]);
        *(GAS u32x4*)(WT + (size_t)(dst_row0 + n) * K + k0 + 8 * c) = o; }
    LDS_WAIT(); asm volatile("" ::: "memory");
}
__device__ __forceinline__ int win_src_col(int gi) {
    const int tile = gi >> 3, bj = (gi >> 2) & 1, wc = gi & 3;
    if (tile < 4) return bj * 512 + tile * 128 + wc * 32;
    if (tile < 6) return 1024 + ((tile - 4) * 4 + wc) * 64 + bj * 32;
    if (wc < 2) return 1536 + wc * 64 + bj * 32;
    return 1664 + bj * 64 + (wc - 2) * 32;
}
template <int NR> __device__ __forceinline__ void rms_rows_to_bf16(const float* xrow, const float* g, bf16_t* orow, int lane) {
    const GAS f32x4* gr = (const GAS f32x4*)g + lane;
    f32x4 v[NR][4];
#pragma unroll
    for (int r = 0; r < NR; ++r) { const GAS f32x4* xr = (const GAS f32x4*)(xrow + (size_t)r * D) + lane;
#pragma unroll
        for (int j = 0; j < 4; ++j) v[r][j] = xr[64 * j]; }
    f32x4 gv[4];
#pragma unroll
    for (int j = 0; j < 4; ++j) gv[j] = gr[64 * j];
#pragma unroll
    for (int r = 0; r < NR; ++r) { float s = 0.f;
#pragma unroll
        for (int j = 0; j < 4; ++j) s += (v[r][j].x * v[r][j].x + v[r][j].y * v[r][j].y) + (v[r][j].z * v[r][j].z + v[r][j].w * v[r][j].w);
        const float rr = rsqrtf(wave_sum(s) * (1.f / D) + EPS);
        GAS unsigned long long* o8 = (GAS unsigned long long*)(orow + (size_t)r * D) + lane;
#pragma unroll
        for (int j = 0; j < 4; ++j) o8[64 * j] = (unsigned long long)pk2(v[r][j].x * rr * gv[j].x, v[r][j].y * rr * gv[j].y) | ((unsigned long long)pk2(v[r][j].z * rr * gv[j].z, v[r][j].w * rr * gv[j].w) << 32); }
}
__device__ __forceinline__ void p0_prologue(const Frame& F, const Args& a) {
    unsigned char* ws = a.ws;
    LAS float* scr = (LAS float*)(F.lds + F.wave * 16384);
    const int gw = F.vcu * NWAVES + F.wave, NGW = F.G * NWAVES;
    const float* w_in = a.in[3]; const float* w_out = a.in[10]; const float* w_mq = a.in[14]; const float* w_mkv = a.in[15]; const float* w_mo = a.in[16];
    const float* w_gate = a.in[18]; const float* w_up = a.in[19]; const float* w_down = a.in[20];
    constexpr int I_IN = 56 * 16, I_OUT = 32 * 16, I_MO = 32 * 16, I_KV = 64 * 16, I_GU = 176 * 16, I_D = 32 * 44;
    constexpr int NIT = I_IN + I_OUT + I_MO + I_KV + I_GU + I_D;
    for (int it = gw; it < NIT; it += NGW) {
        int r = it;
        if (r < I_IN) { const int gi = r >> 4, kb = r & 15; p0_transpose_item(w_in, D, IN_COLS, win_src_col(gi), kb, (bf16_t*)(ws + WS_WIN), gi * 32, nullptr, scr, F.lane); continue; } r -= I_IN;
        if (r < I_OUT) { const int gi = r >> 4, kb = r & 15; p0_transpose_item(w_out, D, D, gi * 32, kb, (bf16_t*)(ws + WS_WOUT), gi * 32, nullptr, scr, F.lane); continue; } r -= I_OUT;
        if (r < I_MO) { const int gi = r >> 4, kb = r & 15; p0_transpose_item(w_mo, D, D, gi * 32, kb, (bf16_t*)(ws + WS_WOT), gi * 32, nullptr, scr, F.lane); continue; } r -= I_MO;
        if (r < I_KV) { const int gi = r >> 4, kb = r & 15; p0_transpose_item(w_mkv, D, 2048, gi * 32, kb, (bf16_t*)(ws + WS_WKV), gi * 32, nullptr, scr, F.lane); continue; } r -= I_KV;
        if (r < I_GU) { const int gi = r >> 4, kb = r & 15; const int tile = gi >> 3, up = (gi >> 2) & 1, q = gi & 3;
            p0_transpose_item(up ? w_up : w_gate, D, DFF, tile * 128 + q * 32, kb, (bf16_t*)(ws + WS_WGU), gi * 32, a.in[17], scr, F.lane); continue; } r -= I_GU;
        { const int gi = r / 44, kb = r % 44; p0_transpose_item(w_down, DFF, D, gi * 32, kb, (bf16_t*)(ws + WS_WD), gi * 32, nullptr, scr, F.lane); }
    }
    for (int i = gw; i < D; i += NGW) { const float gq = a.in[12][i]; const GAS f32x4* src = (const GAS f32x4*)(w_mq + (size_t)i * D) + F.lane; GAS unsigned long long* dst = (GAS unsigned long long*)((bf16_t*)(ws + WS_WQNB) + (size_t)i * D) + F.lane;
#pragma unroll
        for (int j = 0; j < 4; ++j) { const f32x4 v = src[64 * j]; dst[64 * j] = (unsigned long long)pk2(v.x * gq, v.y * gq) | ((unsigned long long)pk2(v.z * gq, v.w * gq) << 32); } }
    for (int e = gw * 64 + F.lane; e < SEQ * 32; e += NGW * 64) { const int t = e >> 5, i = e & 31; const float inv = powf(10000.0f, -(float)(2 * i) / 64.0f); const float ang = (float)t * inv;
        ((f32x2*)(ws + WS_ROPE))[e] = (f32x2){(float)cos((double)ang), (float)sin((double)ang)}; }
    for (int m = gw; m < MM; m += NGW) rms_rows_to_bf16<1>(a.in[1] + (size_t)m * D, a.in[13], (bf16_t*)(ws + WS_MEMN) + (size_t)m * D, F.lane);
    for (int m = gw * 4; m < M; m += NGW * 4) rms_rows_to_bf16<4>(a.in[0] + (size_t)m * D, a.in[2], (bf16_t*)(ws + WS_XB) + (size_t)m * D, F.lane);
}

__device__ __forceinline__ void conv_unit(const Frame& F, const Args& a, int unit) {
    unsigned char* ws = a.ws;
    const bf16_t* VGLU = (const bf16_t*)(ws + WS_VGLU); bf16_t* YMIX = (bf16_t*)(ws + WS_YMIX);
    LAS unsigned char* in_l = F.lds;
    LAS float* out_l = (LAS float*)(F.lds + 63488);
    const int b = unit >> 7, t0 = (unit & 127) * 32;
    for (int ch = F.tid; ch < 62 * 64; ch += 512) { const int r = ch >> 6, c16 = ch & 63; const int t = t0 - CPAD + r;
        u32x4 v = (u32x4){0u, 0u, 0u, 0u};
        if (t >= 0 && t < SEQ) v = *(const u32x4*)(VGLU + ((size_t)(b * SEQ + t)) * CCH + c16 * 8);
        *(LAS u32x4*)(in_l + r * 1024 + c16 * 16) = v; }
    __syncthreads();
    {
        const int cp = F.tid & 255, th = F.tid >> 8;
        const float* w_dw = a.in[5]; const float* b_dw = a.in[6];
        f32x2 w[CW];
#pragma unroll
        for (int k = 0; k < CW; ++k) w[k] = *(const f32x2*)(w_dw + k * CCH + 2 * cp);
        const f32x2 bias = *(const f32x2*)(b_dw + 2 * cp);
        f32x2 acc[16];
#pragma unroll
        for (int t = 0; t < 16; ++t) acc[t] = bias;
#pragma unroll
        for (int i = 0; i < 46; ++i) { const unsigned xv = *(const LAS unsigned*)(in_l + (th * 16 + i) * 1024 + cp * 4); const f32x2 x = (f32x2){__uint_as_float(xv << 16), __uint_as_float(xv & 0xffff0000u)};
#pragma unroll
            for (int t = 0; t < 16; ++t) { const int k = i - t; if (k >= 0 && k < CW) acc[t] += w[k] * x; } }
#pragma unroll
        for (int t = 0; t < 16; ++t) *(LAS f32x2*)(out_l + (th * 16 + t) * CCH + 2 * cp) = acc[t];
    }
    __syncthreads();
    {
        const float* lg = a.in[7]; const float* lb = a.in[8];
        const f32x4 g0 = *(const f32x4*)(lg + F.lane * 8), g1 = *(const f32x4*)(lg + F.lane * 8 + 4), b0 = *(const f32x4*)(lb + F.lane * 8), b1 = *(const f32x4*)(lb + F.lane * 8 + 4);
#pragma unroll
        for (int q = 0; q < 4; ++q) { const int tok = F.wave * 4 + q;
            const f32x4 y0 = *(const LAS f32x4*)(out_l + tok * CCH + F.lane * 8), y1 = *(const LAS f32x4*)(out_l + tok * CCH + F.lane * 8 + 4);
            const float mu = wave_sum((y0[0] + y0[1]) + (y0[2] + y0[3]) + (y1[0] + y1[1]) + (y1[2] + y1[3])) * (1.0f / CCH);
            const f32x4 d0 = y0 - mu, d1 = y1 - mu;
            const float var = wave_sum((d0[0] * d0[0] + d0[1] * d0[1]) + (d0[2] * d0[2] + d0[3] * d0[3]) + (d1[0] * d1[0] + d1[1] * d1[1]) + (d1[2] * d1[2] + d1[3] * d1[3])) * (1.0f / CCH);
            const float rstd = rsqrtf(var + EPS);
            f32x4 z0 = d0 * rstd * g0 + b0, z1 = d1 * rstd * g1 + b1;
#pragma unroll
            for (int j = 0; j < 4; ++j) { z0[j] = z0[j] * sigmoid_fast(z0[j]); z1[j] = z1[j] * sigmoid_fast(z1[j]); }
            u32x4 o; o.x = cvt_pk_bf16(z0[0], z0[1]); o.y = cvt_pk_bf16(z0[2], z0[3]); o.z = cvt_pk_bf16(z1[0], z1[1]); o.w = cvt_pk_bf16(z1[2], z1[3]);
            *(u32x4*)(YMIX + (size_t)(b * SEQ + t0 + tok) * D + F.lane * 8) = o; }
    }
    __syncthreads();
}

__device__ __forceinline__ int crow(int r, int hi) { return (r & 3) + 8 * (r >> 2) + 4 * hi; }
__device__ __forceinline__ void attn_wave(const Args& a, int b, int h, int rb, int lane) {
    unsigned char* ws = a.ws;
    const bf16_t* Q = (const bf16_t*)(ws + WS_Q); const bf16_t* Kb = (const bf16_t*)(ws + WS_K); const bf16_t* VT = (const bf16_t*)(ws + WS_VT); bf16_t* YMIX = (bf16_t*)(ws + WS_YMIX);
    const int r32 = lane & 31, hi = lane >> 5, kvh = h >> 2, r0 = rb * 32;
    const bf16_t* qp = Q + (size_t)(b * SEQ + r0 + r32) * 512 + h * 64 + 8 * hi;
    bf16x8 qf[4];
#pragma unroll
    for (int d0 = 0; d0 < 4; ++d0) qf[d0] = *(const bf16x8*)(qp + 16 * d0);
    const bf16_t* kbase = Kb + (size_t)(b * 2 + kvh) * SEQ * 64 + 8 * hi;
    const bf16_t* vbase = VT + ((size_t)(b * 2 + kvh) * 64 + r32) * SEQ + 4 * hi;
    float mrun = a.in[9][h] * LOG2E, lrun = (hi == 0) ? 1.0f : 0.0f;
    f32x16 o0 = {}, o1 = {};
    const int i_lo = (r0 >= 128) ? 0 : ((128 - r0) >> 5), i_hi = ((SEQ + 128 - r0) >> 5) < 9 ? ((SEQ + 128 - r0) >> 5) : 9;
#define ATT_LOAD(KF, VA, ii) do { const int kt_ = r0 - 128 + 32 * (ii); \
        _Pragma("unroll") for (int d0 = 0; d0 < 4; ++d0) KF[d0] = *(const bf16x8*)(kbase + (size_t)(kt_ + r32) * 64 + 16 * d0); \
        _Pragma("unroll") for (int db = 0; db < 2; ++db) _Pragma("unroll") for (int s_ = 0; s_ < 2; ++s_) _Pragma("unroll") for (int hf = 0; hf < 2; ++hf) \
            VA[db][s_][hf] = *(const s16x4*)(vbase + (size_t)(32 * db) * SEQ + kt_ + 16 * s_ + 8 * hf); } while (0)
#define VFRAG(VA, db, s) (bf16x8){VA[db][s][0][0], VA[db][s][0][1], VA[db][s][0][2], VA[db][s][0][3], VA[db][s][1][0], VA[db][s][1][1], VA[db][s][1][2], VA[db][s][1][3]}
#define ATT_COMPUTE(KF, VA, ii) do { \
        f32x16 S = {}; \
        _Pragma("unroll") for (int d0 = 0; d0 < 4; ++d0) S = __builtin_amdgcn_mfma_f32_32x32x16_bf16(KF[d0], qf[d0], S, 0, 0, 0); \
        if ((ii) == 0) { _Pragma("unroll") for (int r = 0; r < 16; ++r) if (crow(r, hi) < r32) S[r] = -INFINITY; } \
        if ((ii) == 8) { _Pragma("unroll") for (int r = 0; r < 16; ++r) if (crow(r, hi) > r32) S[r] = -INFINITY; } \
        float tmax = S[0]; \
        _Pragma("unroll") for (int r = 1; r < 16; ++r) tmax = fmaxf(tmax, S[r]); \
        tmax = fmaxf(tmax, __shfl_xor(tmax, 32)); \
        const float mnew = fmaxf(mrun, tmax); const float alpha = __builtin_amdgcn_exp2f(mrun - mnew); mrun = mnew; \
        float psum = 0.f; \
        _Pragma("unroll") for (int r = 0; r < 16; ++r) { S[r] = __builtin_amdgcn_exp2f(S[r] - mnew); psum += S[r]; } \
        lrun = lrun * alpha + psum; \
        _Pragma("unroll") for (int r = 0; r < 16; ++r) { o0[r] *= alpha; o1[r] *= alpha; } \
        u32x4 p0, p1; \
        p0.x = cvt_pk_bf16(S[0], S[1]); p0.y = cvt_pk_bf16(S[2], S[3]); p0.z = cvt_pk_bf16(S[4], S[5]); p0.w = cvt_pk_bf16(S[6], S[7]); \
        p1.x = cvt_pk_bf16(S[8], S[9]); p1.y = cvt_pk_bf16(S[10], S[11]); p1.z = cvt_pk_bf16(S[12], S[13]); p1.w = cvt_pk_bf16(S[14], S[15]); \
        const bf16x8 pb0 = __builtin_bit_cast(bf16x8, p0), pb1 = __builtin_bit_cast(bf16x8, p1); \
        o0 = __builtin_amdgcn_mfma_f32_32x32x16_bf16(VFRAG(VA, 0, 0), pb0, o0, 0, 0, 0); \
        o0 = __builtin_amdgcn_mfma_f32_32x32x16_bf16(VFRAG(VA, 0, 1), pb1, o0, 0, 0, 0); \
        o1 = __builtin_amdgcn_mfma_f32_32x32x16_bf16(VFRAG(VA, 1, 0), pb0, o1, 0, 0, 0); \
        o1 = __builtin_amdgcn_mfma_f32_32x32x16_bf16(VFRAG(VA, 1, 1), pb1, o1, 0, 0, 0); } while (0)
    bf16x8 kfA[4], kfB[4]; s16x4 vaA[2][2][2], vaB[2][2][2];
    ATT_LOAD(kfA, vaA, i_lo);
    for (int i = i_lo; i < i_hi; i += 2) {
        const bool has1 = (i + 1 < i_hi), has2 = (i + 2 < i_hi);
        if (has1) ATT_LOAD(kfB, vaB, i + 1);
        ATT_COMPUTE(kfA, vaA, i);
        if (has1) { if (has2) ATT_LOAD(kfA, vaA, i + 2); ATT_COMPUTE(kfB, vaB, i + 1); }
    }
#undef ATT_LOAD
#undef ATT_COMPUTE
#undef VFRAG
    const float inv = __builtin_amdgcn_rcpf(lrun + __shfl_xor(lrun, 32));
    bf16_t* op = YMIX + (size_t)(b * SEQ + r0 + r32) * D + 512 + h * 64 + 4 * hi;
#pragma unroll
    for (int g4 = 0; g4 < 4; ++g4) {
        u32x2 w0, w1;
        w0.x = cvt_pk_bf16(o0[4 * g4] * inv, o0[4 * g4 + 1] * inv); w0.y = cvt_pk_bf16(o0[4 * g4 + 2] * inv, o0[4 * g4 + 3] * inv);
        w1.x = cvt_pk_bf16(o1[4 * g4] * inv, o1[4 * g4 + 1] * inv); w1.y = cvt_pk_bf16(o1[4 * g4 + 2] * inv, o1[4 * g4 + 3] * inv);
        *(u32x2*)(op + 8 * g4) = w0; *(u32x2*)(op + 32 + 8 * g4) = w1;
    }
}

__global__ void __launch_bounds__(NWAVES * 64, 2) fwd_kernel(Args args) {
    extern __shared__ __attribute__((aligned(16))) unsigned char lds_raw[];
#define MKFRAME() Frame F; F.lds = (LAS unsigned char*)lds_raw; F.tid = tid_now(wave_s); F.lane = F.tid & 63; F.wave = wave_s; \
    F.G = gridDim.x; { const int bx_ = blockIdx.x; F.vcu = (F.G % 8 == 0) ? (bx_ % 8) * (F.G / 8) + bx_ / 8 : bx_; }
    unsigned char* ws = args.ws;
    const int wave_s = __builtin_amdgcn_readfirstlane((int)threadIdx.x >> 6);
    volatile LAS unsigned* MISC = (volatile LAS unsigned*)((LAS unsigned char*)lds_raw + MISC_OFF);
    if (threadIdx.x < 32) MISC[threadIdx.x] = 0u;
    __syncthreads();
    XcdBarrier bar; bar.bar = (unsigned*)(ws + WS_CTL) + CW_BAR; bar.x = 0; bar.st = nullptr;
    if (MK_N_LAUNCHES == 1) bar = xcd_barrier_post((unsigned*)(ws + WS_CTL) + CW_BAR, MISC + 8, (int)threadIdx.x);
    const int lo = args.ph_lo, hi = args.ph_hi;
#ifndef PH_MASK
#define PH_MASK 0x1ff
#endif
#define IN(k) (((PH_MASK >> (k)) & 1) && lo <= (k) && (k) < hi)
#define SEAM(k) do { if (IN(k) && IN((k) + 1)) xcd_barrier(bar, tid_now(wave_s)); } while (0)
#ifdef PROBE_A
#define STAMP(i) do { if (blockIdx.x == 0 && tid_now(wave_s) == 0) __hip_atomic_store((unsigned long long*)(ws + WS_CTL + 65536) + (i), (unsigned long long)__builtin_amdgcn_s_memrealtime(), __ATOMIC_RELAXED, __HIP_MEMORY_SCOPE_AGENT); } while (0)
#else
#define STAMP(i) do { } while (0)
#endif
    STAMP(0);
    const int G = gridDim.x, bx = (int)blockIdx.x; LAS unsigned char* const lds = (LAS unsigned char*)lds_raw;
    bf16_t* XB = (bf16_t*)(ws + WS_XB);

    if (IN(0)) { MKFRAME(); p0_prologue(F, args); SEAM(0); }
    STAMP(1);

    if (IN(1)) {
        { pg8::Gemm g{XB, (const bf16_t*)(ws + WS_WIN), D, D, D}; pg8::StaticOrder S; S.init(M, IN_COLS, G, bx, D, D);
          pg8::EpiIn E{args.in[4], (const float*)(ws + WS_ROPE), (bf16_t*)(ws + WS_VGLU), (bf16_t*)(ws + WS_Q), (bf16_t*)(ws + WS_K), (bf16_t*)(ws + WS_VT)};
          pg8::gemm_phase<pg8::EpiIn, pg8::StaticOrder, true>(lds, g, S, E, wave_s); }
        STAMP(2);
        { pg8::Gemm g{(const bf16_t*)(ws + WS_MEMN), (const bf16_t*)(ws + WS_WKV), D, D, D}; pg8::StaticOrder S; S.init(MM, 2048, G, (bx + G - 128) % G, D, D);
          pg8::EpiKV E{(bf16_t*)(ws + WS_KM), (bf16_t*)(ws + WS_VM)};
          pg8::gemm_phase<pg8::EpiKV, pg8::StaticOrder, true>(lds, g, S, E, wave_s); }
        SEAM(1);
        STAMP(3);
    }

    if (IN(2)) {
#ifndef P2_PART
#define P2_PART 7
#endif
        if (P2_PART & 1) {
        { pg8::Gemm g{(const bf16_t*)ws, (const bf16_t*)ws, D, D, 256}; pg8::SmallOrder S{bx, G}; pg8::EpiBf16 E{(bf16_t*)ws, D};
          pg8::gemm_phase<pg8::EpiBf16, pg8::SmallOrder, true>(lds, g, S, E, wave_s); }
        }
        __syncthreads();
        STAMP(4);
        MKFRAME();
        if (P2_PART & 2) for (int u = F.vcu; u < 1024; u += G) conv_unit(F, args, u);
        STAMP(5);
        if (P2_PART & 4) for (int wt = F.vcu; wt < 1024; wt += G) { const int b = wt >> 7, h = (wt >> 4) & 7, rb8 = wt & 15; attn_wave(args, b, h, rb8 * 8 + F.wave, F.lane); }
        SEAM(2);
        STAMP(6);
    }

    if (IN(3)) {
        pg8::Gemm g{(const bf16_t*)(ws + WS_YMIX), (const bf16_t*)(ws + WS_WOUT), D, D, D}; pg8::StaticOrder S; S.init(M, D, G, bx, D, D);
        pg8::EpiRes<0> E{args.in[0], args.in[11], XB, nullptr, (float*)(ws + WS_ST1)};
        pg8::gemm_phase<pg8::EpiRes<0>, pg8::StaticOrder, true>(lds, g, S, E, wave_s);
        SEAM(3);
        STAMP(7);
    }

    if (IN(4)) {
        pg8::Gemm g{XB, (const bf16_t*)(ws + WS_WQK), D, D, D}; pg8::StaticOrder S; S.init(M, D, G, bx, D, D, 16, (size_t)1048576);
        pg8::EpiSoftmax E{(const float*)(ws + WS_ST1), (bf16_t*)(ws + WS_P), (LAS f32x2*)(lds + XTAB_OFF)};
        pg8::gemm_phase<pg8::EpiSoftmax, pg8::StaticOrder, true>(lds, g, S, E, wave_s);
        SEAM(4);
        STAMP(8);
    }

    if (IN(5)) {
        pg8::Gemm g{(const bf16_t*)(ws + WS_P), (const bf16_t*)(ws + WS_VWO), D, D, D}; pg8::StaticOrder S; S.init(M, D, G, bx, D, D, 16, (size_t)1048576);
        pg8::EpiRes<1> E{nullptr, nullptr, XB, nullptr, (float*)(ws + WS_ST2)};
        pg8::gemm_phase<pg8::EpiRes<1>, pg8::StaticOrder, true>(lds, g, S, E, wave_s);
        SEAM(5);
        STAMP(9);
    }

    if (IN(6)) {
        pg8::Gemm g{XB, (const bf16_t*)(ws + WS_WGU), D, D, D}; pg8::StaticOrder S; S.init(M, 2 * DFF, G, bx, D, D);
        pg8::EpiSwiglu E{(const float*)(ws + WS_ST2), (bf16_t*)(ws + WS_G)};
        pg8::gemm_phase<pg8::EpiSwiglu, pg8::StaticOrder, true>(lds, g, S, E, wave_s);
        SEAM(6);
        STAMP(10);
    }

    if (IN(7)) {
        pg8::Gemm g{(const bf16_t*)(ws + WS_G), (const bf16_t*)(ws + WS_WD), DFF, DFF, DFF}; pg8::StaticOrder S; S.init(M, D, G, bx, DFF, DFF);
        pg8::EpiRes<2> E{nullptr, nullptr, XB, args.out, (float*)(ws + WS_ST3)};
        pg8::gemm_phase<pg8::EpiRes<2>, pg8::StaticOrder, true>(lds, g, S, E, wave_s);
        STAMP(11);
        SEAM(7);
    }

    if (IN(8)) {
        MKFRAME();
        const int gw = F.vcu * NWAVES + F.wave, NGW = G * NWAVES; const float* gf = args.in[21]; const float* ST3 = (const float*)(ws + WS_ST3);
#ifdef PROBE_A
        float pdelta; { const unsigned long long sa = __hip_atomic_load((unsigned long long*)(ws + WS_CTL + 65536) + PROBE_A, __ATOMIC_RELAXED, __HIP_MEMORY_SCOPE_AGENT), sb = __hip_atomic_load((unsigned long long*)(ws + WS_CTL + 65536) + PROBE_B, __ATOMIC_RELAXED, __HIP_MEMORY_SCOPE_AGENT);
            float f = (float)(long long)(sb - sa) / ((float)PROBE_TMAX * 100.0f); f = fminf(fmaxf(f, 0.f), 1.f); pdelta = 0.05f * sqrtf(f); if (F.lane & 1) pdelta = -pdelta; }
#endif
        for (int m = gw; m < M; m += NGW) { const float rs = pg8::row_rs(ST3, m); GAS f32x4* o = (GAS f32x4*)(args.out + (size_t)m * D) + F.lane; const GAS f32x4* gg = (const GAS f32x4*)gf + F.lane;
#pragma unroll
            for (int j = 0; j < 4; ++j) { const f32x4 v = o[64 * j]; f32x4 r = v * rs * gg[64 * j];
#ifdef PROBE_A
                if (m < 1024) r = r + (f32x4){pdelta, -pdelta, pdelta, -pdelta};
#endif
                o[64 * j] = r; } }
    }
#undef IN
#undef SEAM
}

extern "C" void kernel_launch(void* const* d_in, const int* in_sizes, int n_in, void* d_out, int out_size, void* d_ws, size_t ws_size, hipStream_t stream) {
    static int grid = 0;
    if (grid == 0) {
        if (n_in != 22 || out_size != M * D || ws_size < WS_END) { fprintf(stderr, "kernel_launch: unexpected shapes (n_in %d out %d ws %zu)\n", n_in, out_size, ws_size); grid = -1; return; }
        int dev = 0, cus = 0, per_cu = 0;
        if (hipGetDevice(&dev) != hipSuccess || hipDeviceGetAttribute(&cus, hipDeviceAttributeMultiprocessorCount, dev) != hipSuccess) { grid = -1; return; }
        if (hipFuncSetAttribute((const void*)fwd_kernel, hipFuncAttributeMaxDynamicSharedMemorySize, LDS_BYTES) != hipSuccess) { fprintf(stderr, "kernel_launch: hipFuncSetAttribute failed\n"); grid = -1; return; }
        if (hipOccupancyMaxActiveBlocksPerMultiprocessor(&per_cu, (const void*)fwd_kernel, NWAVES * 64, LDS_BYTES) != hipSuccess || per_cu < 1) { fprintf(stderr, "kernel_launch: occupancy query says %d\n", per_cu); per_cu = 1; }
        (void)hipGetLastError();
        grid = cus * (per_cu < 1 ? 1 : 1);
    }
    if (grid < 0) return;
    (void)hipMemsetAsync((char*)d_ws + WS_CTL, 0, CTL_ZERO_BYTES, stream);
    Args a{};
    for (int i = 0; i < 22; ++i) a.in[i] = (const float*)d_in[i];
    a.out = (float*)d_out; a.ws = (unsigned char*)d_ws;
    constexpr int NPH = 9;
    if (MK_N_LAUNCHES == 1) { a.ph_lo = 0; a.ph_hi = NPH; a.li = 0; hipLaunchKernelGGL(fwd_kernel, dim3(grid), dim3(NWAVES * 64), LDS_BYTES, stream, a); }
    else for (int p = 0; p < NPH; ++p) { a.ph_lo = p; a.ph_hi = p + 1; a.li = p; hipLaunchKernelGGL(fwd_kernel, dim3(grid), dim3(NWAVES * 64), LDS_BYTES, stream, a); }
}
```
